# Optimizing an MI355X kernel written in HIP

```python
import jax, jax.numpy as jnp
from jax import lax
import numpy as np

D_MODEL = 2048
BATCH = 2
SEQ = 8192
DEPTH = 1

CHUNK = 64
GDN_HEADS = 16
GDN_DK = 128
GDN_DV = 128
GDN_CONV = 4
QK_W = GDN_HEADS * GDN_DK
V_W = GDN_HEADS * GDN_DV
QKV_W = 2 * QK_W + V_W
POOL_WINDOWS = (2, 4, 8, 16)
POOL_WIDTH = D_MODEL // 2
POOL_GROUP = POOL_WIDTH // 4
XA_HEADS = 4
XA_HEAD_DIM = D_MODEL // XA_HEADS
MEM_LEN = 256
D_FF = 5504
FFN_CONV = 3
EPS = 1e-6
IN_SIZES = (QKV_W, V_W, GDN_HEADS, GDN_HEADS, POOL_WIDTH, D_MODEL, D_MODEL)
D_IN = QKV_W + V_W + 2 * GDN_HEADS + POOL_WIDTH + 2 * D_MODEL

kernel_name = "hybrid_gdn_pool_xattn_convffn_block"


def rms_norm(x, w):
    xf = x.astype(jnp.float32)
    y = xf * lax.rsqrt(jnp.mean(xf * xf, axis=-1, keepdims=True) + EPS)
    return (y * w.astype(jnp.float32)).astype(x.dtype)


def l2_norm(x):
    return x * lax.rsqrt(jnp.sum(x * x, axis=-1, keepdims=True) + EPS)


def causal_dwconv(x, w):
    K = w.shape[0]
    S = x.shape[1]
    xp = jnp.pad(x, ((0, 0), (K - 1, 0), (0, 0)))
    y = xp[:, K - 1:K - 1 + S] * w[K - 1]
    for j in range(K - 1):
        y = y + xp[:, j:j + S] * w[j]
    return y


def gated_delta_rule(q, k, v, g, beta):
    B, S, H, DK = q.shape
    DV = v.shape[-1]
    N = S // CHUNK

    def blocks(t):
        return t.reshape(B, N, CHUNK, H, -1).transpose(0, 3, 1, 2, 4)

    q, k, v = blocks(q), blocks(k), blocks(v)
    g = blocks(g[..., None])[..., 0]
    beta = blocks(beta[..., None])[..., 0]
    G = jnp.cumsum(g, axis=-1)
    pos = jnp.arange(CHUNK)
    incl = pos[:, None] >= pos[None, :]
    strict = pos[:, None] > pos[None, :]
    gap = G[..., :, None] - G[..., None, :]
    decay = jnp.where(incl, jnp.exp(jnp.where(incl, gap, 0.0)), 0.0)
    kk = jnp.einsum('bhnid,bhnjd->bhnij', k, k)
    lower = jnp.where(strict, beta[..., :, None] * decay * kk, 0.0)
    system = lower + jnp.eye(CHUNK, dtype=lower.dtype)
    rhs = jnp.concatenate([beta[..., None] * v, (beta * jnp.exp(G))[..., None] * k], axis=-1)
    sol = lax.linalg.triangular_solve(system, rhs, left_side=True, lower=True,
                                      unit_diagonal=True)
    u_v, w_k = sol[..., :DV], sol[..., DV:]
    attn = decay * jnp.einsum('bhnid,bhnjd->bhnij', q, k)
    q_dec = q * jnp.exp(G)[..., None]
    k_dec = k * jnp.exp(G[..., -1:] - G)[..., None]
    chunk_decay = jnp.exp(G[..., -1])

    def step(state, xs):
        u_c, w_c, a_c, qd_c, kd_c, cd_c = xs
        u = u_c - jnp.einsum('bhck,bhkv->bhcv', w_c, state)
        o = jnp.einsum('bhck,bhkv->bhcv', qd_c, state) + jnp.einsum('bhij,bhjv->bhiv', a_c, u)
        state = cd_c[..., None, None] * state + jnp.einsum('bhck,bhcv->bhkv', kd_c, u)
        return state, o

    xs = tuple(jnp.moveaxis(t, 2, 0) for t in (u_v, w_k, attn, q_dec, k_dec, chunk_decay))
    state0 = jnp.zeros((B, H, DK, DV), jnp.float32)
    _, o = lax.scan(step, state0, xs)
    return o.transpose(1, 0, 3, 2, 4).reshape(B, S, H, DV)


def multi_scale_pool(p, pool_w, pool_scale):
    B, S, _ = p.shape
    pf = p.astype(jnp.float32)
    csum = jnp.pad(jnp.cumsum(pf, axis=1), ((0, 0), (1, 0), (0, 0)))
    xs = jnp.split(pf, len(POOL_WINDOWS), axis=-1)
    cs = jnp.split(csum, len(POOL_WINDOWS), axis=-1)
    t = jnp.arange(S)
    outs = []
    for gi, win in enumerate(POOL_WINDOWS):
        lo = jnp.maximum(t + 1 - win, 0)
        cnt = jnp.minimum(t + 1, win).astype(jnp.float32)
        mean = (cs[gi][:, 1:] - cs[gi][:, lo]) / cnt[None, :, None]
        outs.append(mean - xs[gi])
    y = jnp.stack(outs, axis=2)
    y = jnp.einsum('bsgc,gcd->bsgd', y, pool_w.astype(jnp.float32)).reshape(B, S, POOL_WIDTH)
    return (y * pool_scale.astype(jnp.float32)).astype(p.dtype)


def hybrid_mixer(h, w_in, conv_qkv, a_log, dt_bias, gdn_norm, pool_w, pool_scale,
                 w_branch_a, w_branch_b, w_mix_out):
    B, S, _ = h.shape
    splits = [int(i) for i in np.cumsum(IN_SIZES)[:-1]]
    qkv, z, b_raw, a_raw, p, gate_a, gate_b = jnp.split(h @ w_in, splits, axis=-1)
    qkv = jax.nn.silu(causal_dwconv(qkv, conv_qkv))
    q, k, v = jnp.split(qkv, [QK_W, 2 * QK_W], axis=-1)
    q = l2_norm(q.reshape(B, S, GDN_HEADS, GDN_DK).astype(jnp.float32)) * (GDN_DK ** -0.5)
    k = l2_norm(k.reshape(B, S, GDN_HEADS, GDN_DK).astype(jnp.float32))
    v = v.reshape(B, S, GDN_HEADS, GDN_DV).astype(jnp.float32)
    beta = jax.nn.sigmoid(b_raw.astype(jnp.float32))
    g = -jnp.exp(a_log.astype(jnp.float32)) * jax.nn.softplus(
        a_raw.astype(jnp.float32) + dt_bias.astype(jnp.float32))
    o = gated_delta_rule(q, k, v, g, beta)
    o = rms_norm(o, gdn_norm) * jax.nn.silu(z.reshape(B, S, GDN_HEADS, GDN_DV).astype(jnp.float32))
    y_a = o.reshape(B, S, V_W).astype(h.dtype) @ w_branch_a
    y_b = multi_scale_pool(p, pool_w, pool_scale) @ w_branch_b
    merged = jax.nn.sigmoid(gate_a) * y_a + jax.nn.sigmoid(gate_b) * y_b
    return merged @ w_mix_out


def memory_cross_attention(h, m, w_xq, w_xkv, w_xo):
    B, S, _ = h.shape
    M = m.shape[1]
    q = (h @ w_xq).reshape(B, S, XA_HEADS, XA_HEAD_DIM)
    k, v = jnp.split(m @ w_xkv, 2, axis=-1)
    k = k.reshape(B, M, XA_HEADS, XA_HEAD_DIM)
    v = v.reshape(B, M, XA_HEADS, XA_HEAD_DIM)
    s = jnp.einsum('bshd,bmhd->bhsm', q, k).astype(jnp.float32) * (XA_HEAD_DIM ** -0.5)
    pr = jax.nn.softmax(s, axis=-1).astype(v.dtype)
    o = jnp.einsum('bhsm,bmhd->bshd', pr, v).reshape(B, S, D_MODEL)
    return o @ w_xo


def conv_glu_ffn(h, w_up, ffn_conv_w, ffn_conv_b, w_down):
    u = causal_dwconv(h @ w_up, ffn_conv_w) + ffn_conv_b
    a, b = jnp.split(u, 2, axis=-1)
    return (jax.nn.silu(a) * b) @ w_down


def setup_inputs(seed: int = 0) -> dict:
    key = jax.random.key(seed)
    ks = iter(jax.random.split(key, 32))

    def dense(shape, fan_in):
        return jax.random.normal(next(ks), shape, jnp.float32) * (fan_in ** -0.5)

    def gain(shape):
        return 1.0 + 0.05 * jax.random.normal(next(ks), shape, jnp.float32)

    L = DEPTH
    x = jax.random.normal(next(ks), (BATCH, SEQ, D_MODEL), jnp.float32)
    mem = jax.random.normal(next(ks), (BATCH, MEM_LEN, D_MODEL), jnp.float32)
    a_log = jnp.log(jax.random.uniform(next(ks), (L, GDN_HEADS), jnp.float32, 1.0, 16.0))
    dt = jnp.exp(jax.random.uniform(next(ks), (L, GDN_HEADS), jnp.float32,
                                    np.log(1e-3), np.log(1e-1)))
    dt_bias = dt + jnp.log(-jnp.expm1(-dt))
    return {
        "x": x,
        "mem": mem,
        "mix_pre_norm": gain((L, D_MODEL)),
        "w_in": dense((L, D_MODEL, D_IN), D_MODEL),
        "conv_qkv": dense((L, GDN_CONV, QKV_W), GDN_CONV),
        "a_log": a_log,
        "dt_bias": dt_bias,
        "gdn_norm": gain((L, GDN_DV)),
        "pool_w": dense((L, len(POOL_WINDOWS), POOL_GROUP, POOL_GROUP), POOL_GROUP),
        "pool_scale": gain((L, POOL_WIDTH)),
        "w_branch_a": dense((L, V_W, D_MODEL), V_W),
        "w_branch_b": dense((L, POOL_WIDTH, D_MODEL), POOL_WIDTH),
        "w_mix_out": dense((L, D_MODEL, D_MODEL), D_MODEL),
        "mix_post_norm": gain((L, D_MODEL)),
        "xa_pre_norm": gain((L, D_MODEL)),
        "mem_norm": gain((L, D_MODEL)),
        "w_xq": dense((L, D_MODEL, D_MODEL), D_MODEL),
        "w_xkv": dense((L, D_MODEL, 2 * D_MODEL), D_MODEL),
        "w_xo": dense((L, D_MODEL, D_MODEL), D_MODEL),
        "xa_post_norm": gain((L, D_MODEL)),
        "ffn_pre_norm": gain((L, D_MODEL)),
        "w_up": dense((L, D_MODEL, 2 * D_FF), D_MODEL),
        "ffn_conv_w": dense((L, FFN_CONV, 2 * D_FF), FFN_CONV),
        "ffn_conv_b": 0.01 * jax.random.normal(next(ks), (L, 2 * D_FF), jnp.float32),
        "w_down": dense((L, D_FF, D_MODEL), D_FF),
        "ffn_post_norm": gain((L, D_MODEL)),
    }


def reference(x, mem, mix_pre_norm, w_in, conv_qkv, a_log, dt_bias, gdn_norm, pool_w,
              pool_scale, w_branch_a, w_branch_b, w_mix_out, mix_post_norm, xa_pre_norm,
              mem_norm, w_xq, w_xkv, w_xo, xa_post_norm, ffn_pre_norm, w_up, ffn_conv_w,
              ffn_conv_b, w_down, ffn_post_norm):
    for l in range(DEPTH):
        h = rms_norm(x, mix_pre_norm[l])
        y = hybrid_mixer(h, w_in[l], conv_qkv[l], a_log[l], dt_bias[l], gdn_norm[l], pool_w[l],
                         pool_scale[l], w_branch_a[l], w_branch_b[l], w_mix_out[l])
        x = x + rms_norm(y, mix_post_norm[l])
        h = rms_norm(x, xa_pre_norm[l])
        m = rms_norm(mem, mem_norm[l])
        y = memory_cross_attention(h, m, w_xq[l], w_xkv[l], w_xo[l])
        x = x + rms_norm(y, xa_post_norm[l])
        h = rms_norm(x, ffn_pre_norm[l])
        y = conv_glu_ffn(h, w_up[l], ffn_conv_w[l], ffn_conv_b[l], w_down[l])
        x = x + rms_norm(y, ffn_post_norm[l])
    return x
```

```cpp
#include <hip/hip_runtime.h>
#include <hip/hip_cooperative_groups.h>
#include <cstdio>
#include <cstdint>
namespace cg = cooperative_groups;

#ifndef ONE_LAUNCH
#define ONE_LAUNCH 1
#endif

#define LAS __attribute__((address_space(3)))
typedef unsigned short bf16_t;
typedef short bf16x8 __attribute__((ext_vector_type(8)));
typedef float f32x4 __attribute__((ext_vector_type(4)));
typedef float f32x2 __attribute__((ext_vector_type(2)));
typedef unsigned u32x4 __attribute__((ext_vector_type(4)));
typedef unsigned u32x2 __attribute__((ext_vector_type(2)));

constexpr int T = 16384, D = 2048, SEQ = 8192, DFF = 5504;
constexpr int SLOT = 36864;
constexpr int RAWT = 67 * 128;
constexpr float EPS = 1e-6f;
constexpr int LDS_BYTES = 155648;
constexpr size_t MiB = 1ull << 20;
constexpr size_t OFF_PREP = 0, OFF_W0 = 288 * MiB, OFF_W1 = 313 * MiB, OFF_WZ = 317 * MiB, OFF_WGB = 325 * MiB, OFF_WGA = 333 * MiB,
    OFF_WPOOL = 341 * MiB, OFF_WA = 342 * MiB, OFF_WB = 350 * MiB, OFF_WMIX = 354 * MiB, OFF_WXQ = 362 * MiB, OFF_WXKV = 370 * MiB,
    OFF_WXO = 386 * MiB, OFF_AB = 394 * MiB, OFF_M = 396 * MiB, OFF_KM = 398 * MiB, OFF_VT = 400 * MiB, OFF_CD = 402 * MiB,
    OFF_POOLA = 403 * MiB, OFF_POOLB = 435 * MiB, OFF_WUP = 317 * MiB, OFF_WDOWN = 403 * MiB, OFF_H3 = 435 * MiB,
    OFF_YB = 435 * MiB, OFF_YA = 64 * MiB, OFF_Y = 160 * MiB, OFF_H2 = 0, OFF_Q = 64 * MiB, OFF_P = 128 * MiB, OFF_O = 0,
    OFF_ACT = 0, OFF_YDOWN = 172 * MiB, OFF_SSQ = 500 * MiB, OFF_XB = 236 * MiB, OFF_BAR = 509 * MiB, WS_NEED = 510 * MiB;

struct Params { const float* in[26]; float* out; unsigned char* ws; int st_lo, st_hi; };

typedef __bf16 bf16x2_t __attribute__((ext_vector_type(2)));
__device__ __forceinline__ unsigned cvt_pk_bf16(float lo, float hi) { f32x2 v = {lo, hi}; bf16x2_t b = __builtin_convertvector(v, bf16x2_t); return __builtin_bit_cast(unsigned, b); }
__device__ __forceinline__ float lo_bf(unsigned w) { return __uint_as_float(w << 16); }
__device__ __forceinline__ float hi_bf(unsigned w) { return __uint_as_float(w & 0xffff0000u); }
__device__ __forceinline__ float bf2f(bf16_t b) { return __uint_as_float(((unsigned)b) << 16); }
__device__ __forceinline__ float sigmoid_f(float x) { return __builtin_amdgcn_rcpf(1.0f + __expf(-x)); }
__device__ __forceinline__ float silu_f(float x) { return x * __builtin_amdgcn_rcpf(1.0f + __expf(-x)); }
#define LDS_WAIT() asm volatile("s_waitcnt lgkmcnt(0)" ::: "memory")
#define LDS_BARRIER() do { asm volatile("s_waitcnt lgkmcnt(0)" ::: "memory"); __builtin_amdgcn_s_barrier(); asm volatile("" ::: "memory"); } while (0)
__device__ __forceinline__ float dpp_add(float x, const int ctrl_sel) {
    int y;
    if (ctrl_sel == 0) y = __builtin_amdgcn_update_dpp(0, __float_as_int(x), 0xB1, 0xf, 0xf, true);
    else if (ctrl_sel == 1) y = __builtin_amdgcn_update_dpp(0, __float_as_int(x), 0x4E, 0xf, 0xf, true);
    else if (ctrl_sel == 2) y = __builtin_amdgcn_update_dpp(0, __float_as_int(x), 0x141, 0xf, 0xf, true);
    else y = __builtin_amdgcn_update_dpp(0, __float_as_int(x), 0x140, 0xf, 0xf, true);
    return x + __int_as_float(y);
}
__device__ __forceinline__ float dpp_red16(float x) { x = dpp_add(x, 0); x = dpp_add(x, 1); x = dpp_add(x, 2); x = dpp_add(x, 3); return x; }
__device__ __forceinline__ float wave_sum(float v) { v = dpp_red16(v); v += __shfl_xor(v, 16); v += __shfl_xor(v, 32); return v; }

namespace pg8 {
constexpr int BM = 256, BK = 64, HALF = 128, HTB = HALF * BK * 2, STAGE_BYTES = 8 * HTB, NXCD = 8, WGM = 8;
__host__ __device__ __forceinline__ int lds_byte(int r, int c) { const int st = (r >> 4) * 2 + (c >> 5), rr = r & 15, cc = c & 31, ob = rr * 64 + cc * 2; return st * 1024 + (ob ^ (((ob >> 9) & 1) << 5)); }
__host__ __device__ __forceinline__ void stage_rc(int b, int& R, int& C) { const int st = b / 1024, sb = b % 1024, swz = sb ^ (((sb >> 9) & 1) << 5); R = (st >> 1) * 16 + swz / 64; C = (st & 1) * 32 + (swz % 64) / 2; }
__host__ __device__ __forceinline__ int perm32(int rho) { const int n = rho >> 4, i = rho & 15; return 8 * (i >> 2) + 4 * n + (i & 3); }

struct Unit { const char* a; const char* b; int orow, ocol, pm, pn; };
struct GJob {
    const char* A; const char* B;
    long sA1, sA2, sB1, sB2;
    int lda, ldb;
    int K, nM, nN, G1, G2;
    int rstride;
    int orow0, oR1, oR2, oC1, oC2;
    int G, c;
    int direct;
    __device__ __forceinline__ bool next(int i, Unit& u) const {
        if (direct > 0) {
            if (i >= direct || c >= nM * G1 * G2) return false;
            const int g = c / nM, pm = c % nM, pn = i, g1 = g / G2, g2 = g % G2;
            u.pm = pm; u.pn = pn;
            u.a = A + g1 * sA1 + g2 * sA2 + (long)pm * rstride * lda;
            u.b = B + g1 * sB1 + g2 * sB2 + (long)pn * BM * ldb;
            u.orow = orow0 + g1 * oR1 + g2 * oR2 + pm * rstride;
            u.ocol = g1 * oC1 + g2 * oC2 + pn * BM;
            return true;
        }
        const long L = (long)i * G + c; const int nwg = nM * nN;
        if (L >= (long)nwg * G1 * G2) return false;
        const int g = (int)(L / nwg); int wgid = (int)(L % nwg);
        { const int q = nwg / NXCD, r = nwg % NXCD, xcd = wgid % NXCD, off = wgid / NXCD; wgid = (xcd < r ? xcd * (q + 1) : r * (q + 1) + (xcd - r) * q) + off; }
        const int nig = WGM * nN, gid = wgid / nig, fm = gid * WGM, gsz = (nM - fm) < WGM ? (nM - fm) : WGM;
        const int pm = fm + ((wgid % nig) % gsz), pn = (wgid % nig) / gsz;
        const int g1 = g / G2, g2 = g % G2;
        u.pm = pm; u.pn = pn;
        u.a = A + g1 * sA1 + g2 * sA2 + (long)pm * rstride * lda;
        u.b = B + g1 * sB1 + g2 * sB2 + (long)pn * BM * ldb;
        u.orow = orow0 + g1 * oR1 + g2 * oR2 + pm * rstride;
        u.ocol = g1 * oC1 + g2 * oC2 + pn * BM;
        return true;
    }
};

template <class Epi>
__device__ __forceinline__ void gemm_phase(LAS unsigned char* lds, const GJob& S, const Epi& E) {
    const int tid = threadIdx.x, wid = __builtin_amdgcn_readfirstlane(tid >> 6), lane = tid & 63, wr = wid >> 2, wc = wid & 3, fr = lane & 15, fq = lane >> 4;
    const int nt = S.K / BK;
    unsigned voffA[2], voffB[2];
#pragma unroll
    for (int i = 0; i < 2; ++i) { int R, C; stage_rc(tid * 16 + i * 8192, R, C); const int Rb = Epi::PERM ? ((R & ~31) + perm32(R & 31)) : R;
        voffA[i] = (unsigned)(R * S.lda + C * 2); voffB[i] = (unsigned)(Rb * S.ldb + C * 2); }
    const size_t kstep = (size_t)(BK * 2);
    const size_t hstepA = (size_t)HALF * S.lda, hstepB = (size_t)HALF * S.ldb;
    const unsigned ldsw = (unsigned)wid * 1024u;
    const int aoff = lds_byte(wr * 64 + fr, fq * 8), boff = lds_byte(wc * 32 + fr, fq * 8);
#define PG8_SA(b, h) (((b) * 2 + (h)) * HTB)
#define PG8_SB(b, h) ((4 + (b) * 2 + (h)) * HTB)
#define PG8_STAGE(bufoff, gbase, voff) do { _Pragma("unroll") for (int _i = 0; _i < 2; ++_i) \
        __builtin_amdgcn_global_load_lds((const unsigned*)((const char*)(gbase) + (voff)[_i]), (LAS unsigned*)(lds + (bufoff) + ldsw + _i * 8192), 16, 0, 0); } while (0)
#define PG8_LDA(dst, b, h) do { _Pragma("unroll") for (int m = 0; m < 4; ++m) _Pragma("unroll") for (int k = 0; k < 2; ++k) dst[m][k] = *(const LAS bf16x8*)(lds + PG8_SA(b, h) + aoff + m * 2048 + k * 1024); } while (0)
#define PG8_LDB(dst, b, h) do { _Pragma("unroll") for (int n = 0; n < 2; ++n) _Pragma("unroll") for (int k = 0; k < 2; ++k) dst[n][k] = *(const LAS bf16x8*)(lds + PG8_SB(b, h) + boff + n * 2048 + k * 1024); } while (0)
#define PG8_MMA(ai, bj, At, Bt) do { __builtin_amdgcn_s_setprio(1); _Pragma("unroll") for (int m = 0; m < 4; ++m) _Pragma("unroll") for (int n = 0; n < 2; ++n) _Pragma("unroll") for (int k = 0; k < 2; ++k) \
        acc[ai][bj][m][n] = __builtin_amdgcn_mfma_f32_16x16x32_bf16(Bt[n][k], At[m][k], acc[ai][bj][m][n], 0, 0, 0); __builtin_amdgcn_s_setprio(0); } while (0)
#define PG8_WAIT_V(n) asm volatile("s_waitcnt vmcnt(" #n ")" ::: "memory")
#define PG8_WAIT_L(n) asm volatile("s_waitcnt lgkmcnt(" #n ")" ::: "memory")
#define PG8_BAR __builtin_amdgcn_s_barrier()
#define PG8_SCHED __builtin_amdgcn_sched_barrier(0)
    Unit cur, nxt; int ui = 0;
    if (!S.next(0, cur)) return;
    f32x4 acc[2][2][4][2];
#pragma unroll
    for (int a = 0; a < 2; ++a)
#pragma unroll
        for (int b = 0; b < 2; ++b)
#pragma unroll
            for (int m = 0; m < 4; ++m)
#pragma unroll
                for (int n = 0; n < 2; ++n) acc[a][b][m][n] = (f32x4){0.f, 0.f, 0.f, 0.f};
    bf16x8 At[4][2], B0[2][2], B1[2][2];
    const char* cA = cur.a; const char* cB = cur.b;
    PG8_STAGE(PG8_SB(0, 0), cB, voffB); PG8_STAGE(PG8_SB(0, 1), cB + hstepB, voffB); PG8_STAGE(PG8_SA(0, 0), cA, voffA); PG8_STAGE(PG8_SA(0, 1), cA + hstepA, voffA);
    if (wr == 1) PG8_BAR;
    PG8_WAIT_V(2); PG8_BAR;
    PG8_STAGE(PG8_SB(1, 0), cB + kstep, voffB); PG8_STAGE(PG8_SA(1, 0), cA + kstep, voffA); PG8_STAGE(PG8_SB(1, 1), cB + hstepB + kstep, voffB);
    PG8_WAIT_V(6); PG8_BAR;
    for (;;) {
        const bool has_next = S.next(ui + 1, nxt);
        const char* nA = has_next ? nxt.a : cA; const char* nB = has_next ? nxt.b : cB;
        for (int t = 0; t < nt; t += 2) {
            const bool last = (t == nt - 2);
            const char* a1 = cA + (size_t)(t + 1) * kstep;
            const char* a2 = last ? nA : cA + (size_t)(t + 2) * kstep; const char* b2 = last ? nB : cB + (size_t)(t + 2) * kstep;
            const char* a3 = a2 + kstep; const char* b3 = b2 + kstep;
            PG8_LDB(B0, 0, 0); PG8_LDB(B1, 0, 1); PG8_SCHED; PG8_LDA(At, 0, 0); PG8_STAGE(PG8_SA(1, 1), a1 + hstepA, voffA);
            PG8_WAIT_V(8); PG8_WAIT_L(0); PG8_BAR; PG8_MMA(0, 0, At, B0); PG8_MMA(0, 1, At, B1); PG8_BAR; PG8_SCHED;
            PG8_LDA(At, 0, 1); PG8_STAGE(PG8_SB(0, 0), b2, voffB); PG8_STAGE(PG8_SB(0, 1), b2 + hstepB, voffB); PG8_STAGE(PG8_SA(0, 0), a2, voffA);
            PG8_WAIT_V(8); PG8_WAIT_L(0); PG8_BAR; PG8_MMA(1, 0, At, B0); PG8_MMA(1, 1, At, B1); PG8_BAR; PG8_SCHED;
            PG8_LDB(B0, 1, 0); PG8_LDB(B1, 1, 1); PG8_SCHED; PG8_LDA(At, 1, 0); PG8_STAGE(PG8_SA(0, 1), a2 + hstepA, voffA);
            PG8_WAIT_V(8); PG8_WAIT_L(0); PG8_BAR; PG8_MMA(0, 0, At, B0); PG8_MMA(0, 1, At, B1); PG8_BAR; PG8_SCHED;
            PG8_LDA(At, 1, 1); PG8_STAGE(PG8_SB(1, 0), b3, voffB); PG8_STAGE(PG8_SB(1, 1), b3 + hstepB, voffB); PG8_STAGE(PG8_SA(1, 0), a3, voffA);
            PG8_WAIT_V(8); PG8_WAIT_L(0); PG8_BAR; PG8_MMA(1, 0, At, B0); PG8_MMA(1, 1, At, B1); PG8_BAR; PG8_SCHED;
        }
        if (wr == 0) PG8_BAR;
        E(acc, cur, wr, wc, fr, fq, lds + STAGE_BYTES);
        if (!has_next) break;
#pragma unroll
        for (int a = 0; a < 2; ++a)
#pragma unroll
            for (int b = 0; b < 2; ++b)
#pragma unroll
                for (int m = 0; m < 4; ++m)
#pragma unroll
                    for (int n = 0; n < 2; ++n) acc[a][b][m][n] = (f32x4){0.f, 0.f, 0.f, 0.f};
        cur = nxt; cA = nA; cB = nB; ++ui;
        if (wr == 1) PG8_BAR;
    }
    PG8_WAIT_V(0);
    PG8_BAR;
#undef PG8_SA
#undef PG8_SB
#undef PG8_STAGE
#undef PG8_LDA
#undef PG8_LDB
#undef PG8_MMA
#undef PG8_WAIT_V
#undef PG8_WAIT_L
#undef PG8_SCHED
}
}
using pg8::GJob; using pg8::Unit;
typedef f32x4 AccT[2][2][4][2];

struct EpiB {
    static constexpr bool PERM = true;
    bf16_t* O; int ldc; int mode; const bf16_t* aux1; const bf16_t* aux2; const float* cscale; const float* ssq; const float* gn;
    __device__ __forceinline__ void operator()(AccT& acc, const Unit& u, int wr, int wc, int fr, int fq, LAS unsigned char*) const {
        const int row0 = u.orow + wr * 64 + fr, col0 = u.ocol + wc * 32 + 8 * fq;
#pragma unroll
        for (int ai = 0; ai < 2; ++ai)
#pragma unroll
            for (int m = 0; m < 4; ++m) {
                const size_t off = (size_t)(row0 + ai * 128 + m * 16) * ldc + col0;
#pragma unroll
                for (int bj = 0; bj < 2; ++bj) {
                    f32x4 v0 = acc[ai][bj][m][0], v1 = acc[ai][bj][m][1];
                    if (mode == 5) {
                        v0 = (f32x4){sigmoid_f(v0[0]), sigmoid_f(v0[1]), sigmoid_f(v0[2]), sigmoid_f(v0[3])}; v1 = (f32x4){sigmoid_f(v1[0]), sigmoid_f(v1[1]), sigmoid_f(v1[2]), sigmoid_f(v1[3])};
                    } else if (mode == 6 || mode == 7) {
                        const u32x4 a = *(const u32x4*)(aux1 + off + bj * 128);
                        v0 *= (f32x4){lo_bf(a.x), hi_bf(a.x), lo_bf(a.y), hi_bf(a.y)}; v1 *= (f32x4){lo_bf(a.z), hi_bf(a.z), lo_bf(a.w), hi_bf(a.w)};
                        if (mode == 7) { const u32x4 c = *(const u32x4*)(aux2 + off + bj * 128);
                            v0 += (f32x4){lo_bf(c.x), hi_bf(c.x), lo_bf(c.y), hi_bf(c.y)}; v1 += (f32x4){lo_bf(c.z), hi_bf(c.z), lo_bf(c.w), hi_bf(c.w)}; }
                    } else if (mode >= 1 && mode <= 3) {
                        const u32x4 a = *(const u32x4*)(aux1 + off + bj * 128);
                        const float a0 = lo_bf(a.x), a1 = hi_bf(a.x), a2 = lo_bf(a.y), a3 = hi_bf(a.y), a4 = lo_bf(a.z), a5 = hi_bf(a.z), a6 = lo_bf(a.w), a7 = hi_bf(a.w);
                        if (mode == 1) {
                            const int cg = col0 + bj * 128, hd = cg >> 7, cm = cg & 127;
                            const float* sp = ssq + (size_t)(row0 + ai * 128 + m * 16) * 128 + hd * 8;
                            const f32x4 s0 = *(const f32x4*)sp, s1 = *(const f32x4*)(sp + 4);
                            const float rs = rsqrtf(((s0[0] + s0[1]) + (s0[2] + s0[3]) + (s1[0] + s1[1]) + (s1[2] + s1[3])) * (1.0f / 128.0f) + EPS);
                            const f32x4 g0 = *(const f32x4*)(gn + cm) * rs, g1 = *(const f32x4*)(gn + cm + 4) * rs;
                            v0 = (f32x4){silu_f(v0[0]) * a0 * g0[0], silu_f(v0[1]) * a1 * g0[1], silu_f(v0[2]) * a2 * g0[2], silu_f(v0[3]) * a3 * g0[3]};
                            v1 = (f32x4){silu_f(v1[0]) * a4 * g1[0], silu_f(v1[1]) * a5 * g1[1], silu_f(v1[2]) * a6 * g1[2], silu_f(v1[3]) * a7 * g1[3]}; }
                        else { v0 = (f32x4){sigmoid_f(v0[0]) * a0, sigmoid_f(v0[1]) * a1, sigmoid_f(v0[2]) * a2, sigmoid_f(v0[3]) * a3};
                               v1 = (f32x4){sigmoid_f(v1[0]) * a4, sigmoid_f(v1[1]) * a5, sigmoid_f(v1[2]) * a6, sigmoid_f(v1[3]) * a7}; }
                        if (mode == 3) { const u32x4 c = *(const u32x4*)(aux2 + off + bj * 128);
                            v0 += (f32x4){lo_bf(c.x), hi_bf(c.x), lo_bf(c.y), hi_bf(c.y)}; v1 += (f32x4){lo_bf(c.z), hi_bf(c.z), lo_bf(c.w), hi_bf(c.w)}; }
                    } else if (mode == 4) {
                        v0 *= *(const f32x4*)(cscale + col0 + bj * 128); v1 *= *(const f32x4*)(cscale + col0 + bj * 128 + 4);
                    }
                    u32x4 w; w.x = cvt_pk_bf16(v0[0], v0[1]); w.y = cvt_pk_bf16(v0[2], v0[3]); w.z = cvt_pk_bf16(v1[0], v1[1]); w.w = cvt_pk_bf16(v1[2], v1[3]);
                    *(u32x4*)(O + off + bj * 128) = w;
                }
            }
    }
};
struct EpiF {
    static constexpr bool PERM = false;
    float* C; int ldc;
    __device__ __forceinline__ void operator()(AccT& acc, const Unit& u, int wr, int wc, int fr, int fq, LAS unsigned char*) const {
        const int row0 = u.orow + wr * 64 + fr, col0 = u.ocol + wc * 32 + 4 * fq;
#pragma unroll
        for (int ai = 0; ai < 2; ++ai)
#pragma unroll
            for (int m = 0; m < 4; ++m) { float* rowp = C + (size_t)(row0 + ai * 128 + m * 16) * ldc + col0;
#pragma unroll
                for (int bj = 0; bj < 2; ++bj)
#pragma unroll
                    for (int n = 0; n < 2; ++n) *(f32x4*)(rowp + bj * 128 + n * 16) = acc[ai][bj][m][n]; }
    }
};
struct EpiQKV {
    static constexpr bool PERM = true;
    bf16_t* prep; float* ab; bf16_t* poola;
    __device__ __forceinline__ void operator()(AccT& acc, const Unit& u, int wr, int wc, int fr, int fq, LAS unsigned char*) const {
        if (u.pn < 24) {
#pragma unroll
            for (int bj = 0; bj < 2; ++bj) {
                const int cb = 2 * u.pn + bj, ty = cb >> 4, hh = cb & 15, d = wc * 32 + 8 * fq;
#pragma unroll
                for (int ai = 0; ai < 2; ++ai)
#pragma unroll
                    for (int m = 0; m < 4; ++m) {
                        const int t = u.orow + ai * 128 + wr * 64 + m * 16 + fr, b = t >> 13, pos = t & 8191, n = pos >> 6, i = pos & 63;
                        const size_t idx = (size_t)((b * 16 + hh) * 128 + n);
                        const f32x4 v0 = acc[ai][bj][m][0], v1 = acc[ai][bj][m][1];
                        u32x4 w; w.x = cvt_pk_bf16(v0[0], v0[1]); w.y = cvt_pk_bf16(v0[2], v0[3]); w.z = cvt_pk_bf16(v1[0], v1[1]); w.w = cvt_pk_bf16(v1[2], v1[3]);
                        *(u32x4*)(prep + idx * SLOT + ty * RAWT + (3 + i) * 128 + d) = w;
                        if (i >= 61 && n < 127) *(u32x4*)(prep + (idx + 1) * SLOT + ty * RAWT + (i - 61) * 128 + d) = w;
                    }
            }
        } else if (u.pn == 24) {
            if (wc == 0) {
#pragma unroll
                for (int ai = 0; ai < 2; ++ai)
#pragma unroll
                    for (int m = 0; m < 4; ++m) { const int t = u.orow + ai * 128 + wr * 64 + m * 16 + fr;
#pragma unroll
                        for (int n = 0; n < 2; ++n) *(f32x4*)(ab + (size_t)t * 32 + 8 * fq + 4 * n) = acc[ai][0][m][n]; }
            }
        } else {
            const int col0 = (u.pn - 25) * 256 + wc * 32 + 8 * fq;
#pragma unroll
            for (int ai = 0; ai < 2; ++ai)
#pragma unroll
                for (int m = 0; m < 4; ++m) { const int t = u.orow + ai * 128 + wr * 64 + m * 16 + fr;
#pragma unroll
                    for (int bj = 0; bj < 2; ++bj) { const f32x4 v0 = acc[ai][bj][m][0], v1 = acc[ai][bj][m][1];
                        u32x4 w; w.x = cvt_pk_bf16(v0[0], v0[1]); w.y = cvt_pk_bf16(v0[2], v0[3]); w.z = cvt_pk_bf16(v1[0], v1[1]); w.w = cvt_pk_bf16(v1[2], v1[3]);
                        *(u32x4*)(poola + (size_t)t * 1024 + col0 + bj * 128) = w; } }
        }
    }
};
struct EpiSM {
    static constexpr bool PERM = true;
    bf16_t* P;
    __device__ __forceinline__ void operator()(AccT& acc, const Unit& u, int wr, int wc, int fr, int fq, LAS unsigned char* ldsx) const {
        const float sc = 0.04419417382415922f * 1.4426950408889634f;
        LAS f32x2* X = (LAS f32x2*)ldsx;
        float mw[2][4];
#pragma unroll
        for (int ai = 0; ai < 2; ++ai)
#pragma unroll
            for (int m = 0; m < 4; ++m) {
                float mx = -3.0e38f;
#pragma unroll
                for (int bj = 0; bj < 2; ++bj)
#pragma unroll
                    for (int n = 0; n < 2; ++n) { const f32x4 v = acc[ai][bj][m][n]; mx = fmaxf(mx, fmaxf(fmaxf(v[0], v[1]), fmaxf(v[2], v[3]))); }
                mx = fmaxf(mx, __shfl_xor(mx, 16)); mx = fmaxf(mx, __shfl_xor(mx, 32));
                float s = 0.f;
#pragma unroll
                for (int bj = 0; bj < 2; ++bj)
#pragma unroll
                    for (int n = 0; n < 2; ++n) { f32x4 v = acc[ai][bj][m][n];
#pragma unroll
                        for (int j = 0; j < 4; ++j) { v[j] = __builtin_amdgcn_exp2f((v[j] - mx) * sc); s += v[j]; }
                        acc[ai][bj][m][n] = v; }
                s += __shfl_xor(s, 16); s += __shfl_xor(s, 32);
                if (fq == 0) X[(ai * 128 + wr * 64 + m * 16 + fr) * 4 + wc] = (f32x2){mx, s};
                mw[ai][m] = mx;
            }
        LDS_WAIT(); __builtin_amdgcn_s_barrier(); asm volatile("" ::: "memory");
#pragma unroll
        for (int ai = 0; ai < 2; ++ai)
#pragma unroll
            for (int m = 0; m < 4; ++m) {
                const int r = ai * 128 + wr * 64 + m * 16 + fr;
                const f32x2 p0 = X[r * 4 + 0], p1 = X[r * 4 + 1], p2 = X[r * 4 + 2], p3 = X[r * 4 + 3];
                const float M = fmaxf(fmaxf(p0.x, p1.x), fmaxf(p2.x, p3.x));
                const float L = p0.y * __builtin_amdgcn_exp2f((p0.x - M) * sc) + p1.y * __builtin_amdgcn_exp2f((p1.x - M) * sc) + p2.y * __builtin_amdgcn_exp2f((p2.x - M) * sc) + p3.y * __builtin_amdgcn_exp2f((p3.x - M) * sc);
                const float f = __builtin_amdgcn_exp2f((mw[ai][m] - M) * sc) / L;
                bf16_t* rowp = P + (size_t)(u.orow + r) * 256 + wc * 32 + 8 * fq;
#pragma unroll
                for (int bj = 0; bj < 2; ++bj) { const f32x4 v0 = acc[ai][bj][m][0] * f, v1 = acc[ai][bj][m][1] * f;
                    u32x4 w; w.x = cvt_pk_bf16(v0[0], v0[1]); w.y = cvt_pk_bf16(v0[2], v0[3]); w.z = cvt_pk_bf16(v1[0], v1[1]); w.w = cvt_pk_bf16(v1[2], v1[3]);
                    *(u32x4*)(rowp + bj * 128) = w; }
            }
    }
};
template <int N> __device__ __forceinline__ f32x4 ror4(f32x4 v) {
    f32x4 r;
#pragma unroll
    for (int j = 0; j < 4; ++j) r[j] = __int_as_float(__builtin_amdgcn_update_dpp(0, __float_as_int(v[j]), 0x120 + N, 0xf, 0xf, true));
    return r;
}
struct EpiCG {
    static constexpr bool PERM = true;
    bf16_t* act; const float* cw; const float* cb;
    __device__ __forceinline__ void operator()(AccT& acc, const Unit& u, int wr, int wc, int fr, int fq, LAS unsigned char* ldsx) const {
        LAS float* X = (LAS float*)ldsx;
        const int lane = fq * 16 + fr;
        if (fr >= 14) {
#pragma unroll
            for (int ai = 0; ai < 2; ++ai)
#pragma unroll
                for (int bj = 0; bj < 2; ++bj)
#pragma unroll
                    for (int n = 0; n < 2; ++n) *(LAS f32x4*)(X + ((2 * ai + wr) * 2 + (fr - 14)) * 256 + bj * 128 + wc * 32 + 8 * fq + 4 * n) = acc[ai][bj][3][n];
        }
        LDS_WAIT(); __builtin_amdgcn_s_barrier(); asm volatile("" ::: "memory");
#pragma unroll
        for (int n = 0; n < 2; ++n) {
            const int ch = u.pn * 128 + wc * 32 + 8 * fq + 4 * n;
            f32x4 w0[2], w1[2], w2[2], bs[2];
#pragma unroll
            for (int bj = 0; bj < 2; ++bj) { const int c = ch + bj * DFF; w0[bj] = *(const f32x4*)(cw + c); w1[bj] = *(const f32x4*)(cw + 2 * DFF + c); w2[bj] = *(const f32x4*)(cw + 4 * DFF + c); bs[bj] = *(const f32x4*)(cb + c); }
#pragma unroll
            for (int ai = 0; ai < 2; ++ai) {
                int blkp = 2 * ai + wr - 1; if (blkp < 0) blkp = 0;
                f32x4 h62[2], h63[2], p1p[2], p2p[2];
#pragma unroll
                for (int bj = 0; bj < 2; ++bj) { h62[bj] = *(const LAS f32x4*)(X + (blkp * 2 + 0) * 256 + bj * 128 + wc * 32 + 8 * fq + 4 * n); h63[bj] = *(const LAS f32x4*)(X + (blkp * 2 + 1) * 256 + bj * 128 + wc * 32 + 8 * fq + 4 * n); p1p[bj] = h63[bj]; p2p[bj] = (fr == 0) ? h62[bj] : h63[bj]; }
#pragma unroll
                for (int m = 0; m < 4; ++m) {
                    const int rt = ai * 128 + wr * 64 + m * 16 + fr, t = u.orow + rt, pos = t & 8191;
                    f32x4 uu[2];
#pragma unroll
                    for (int bj = 0; bj < 2; ++bj) {
                        const f32x4 cur = acc[ai][bj][m][n];
                        const f32x4 p1 = ror4<1>(cur), p2 = ror4<2>(cur);
                        f32x4 prev1 = (fr >= 1) ? p1 : p1p[bj];
                        f32x4 prev2 = (fr >= 2) ? p2 : p2p[bj];
                        p1p[bj] = p1; p2p[bj] = p2;
                        if (pos == 0) prev1 = (f32x4){0.f, 0.f, 0.f, 0.f};
                        if (pos <= 1) prev2 = (f32x4){0.f, 0.f, 0.f, 0.f};
                        uu[bj] = w2[bj] * cur + w1[bj] * prev1 + w0[bj] * prev2 + bs[bj];
                    }
                    u32x2 w; w.x = cvt_pk_bf16(silu_f(uu[0][0]) * uu[1][0], silu_f(uu[0][1]) * uu[1][1]); w.y = cvt_pk_bf16(silu_f(uu[0][2]) * uu[1][2], silu_f(uu[0][3]) * uu[1][3]);
                    if (rt >= 2 && t < T) *(u32x2*)(act + (size_t)t * DFF + ch) = w;
                }
            }
        }
    }
};

struct TDesc { const float* src; bf16_t* dst; int ldw; int K; };
__device__ __forceinline__ void t_load(const TDesc& d, f32x4 (&t)[8], int lane) {
#pragma unroll
    for (int i = 0; i < 8; ++i) t[i] = *(const f32x4*)(d.src + (size_t)(8 * i + (lane >> 3)) * d.ldw + (lane & 7) * 4);
}
__device__ __forceinline__ void t_finish(const TDesc& d, const f32x4 (&t)[8], LAS float* scr, int lane) {
#pragma unroll
    for (int i = 0; i < 8; ++i) { LAS float* sp = scr + (8 * i + (lane >> 3)) * 33 + (lane & 7) * 4; sp[0] = t[i][0]; sp[1] = t[i][1]; sp[2] = t[i][2]; sp[3] = t[i][3]; }
    LDS_WAIT();
    const int c = lane & 7;
#pragma unroll
    for (int j = 0; j < 4; ++j) { const int n = (lane >> 3) + 8 * j; const LAS float* s = scr + (8 * c) * 33 + n;
        u32x4 o; o.x = cvt_pk_bf16(s[0 * 33], s[1 * 33]); o.y = cvt_pk_bf16(s[2 * 33], s[3 * 33]); o.z = cvt_pk_bf16(s[4 * 33], s[5 * 33]); o.w = cvt_pk_bf16(s[6 * 33], s[7 * 33]);
        *(u32x4*)(d.dst + (size_t)n * d.K + 8 * c) = o; }
    LDS_WAIT();
}
#define TJOB(src_, ldw_, Kdim, col0, ncols, dst_, drow0, kind) if (!found) { const int nbk = (ncols) / 32, items = ((Kdim) / 64) * nbk; \
    if (r < items) { const int kb = r / nbk, nb = r % nbk; int dr = (drow0) + nb * 32; \
        if (kind) { const int cc = nb * 32; dr = cc < DFF ? (cc / 128) * 256 + (cc % 128) : ((cc - DFF) / 128) * 256 + 128 + ((cc - DFF) % 128); } \
        d.src = (src_) + (size_t)(kb * 64) * (ldw_) + (col0) + nb * 32; d.dst = (dst_) + (size_t)dr * (Kdim) + kb * 64; d.ldw = (ldw_); d.K = (Kdim); found = true; } else r -= items; }
struct Lookup0 {
    const Params* p;
    __device__ __forceinline__ bool operator()(int it, TDesc& d) const {
        constexpr int DIN = 13344;
        constexpr int NIT = 32 * (192 + 1 + 32 + 64) + 32 * 128;
        if (it >= NIT) return false;
        unsigned char* ws = p->ws; const float* w_in = p->in[3]; int r = it; bool found = false;
        TJOB(w_in, DIN, 2048, 0, 6144, (bf16_t*)(ws + OFF_W0), 0, 0)
        TJOB(w_in, DIN, 2048, 8192, 32, (bf16_t*)(ws + OFF_W0), 6144, 0)
        TJOB(w_in, DIN, 2048, 8224, 1024, (bf16_t*)(ws + OFF_W1), 0, 0)
        TJOB(w_in, DIN, 2048, 11296, 2048, (bf16_t*)(ws + OFF_WGB), 0, 0)
        TJOB(p->in[17], 4096, 2048, 0, 4096, (bf16_t*)(ws + OFF_WXKV), 0, 0)
        return found;
    }
};
struct LookupDeferred {
    const Params* p;
    __device__ __forceinline__ bool operator()(int it, TDesc& d) const {
        constexpr int DIN = 13344;
        constexpr int NIT = 32 * (64 + 64) + 4 * 4 * 8 + 32 * 64 + 16 * 64 + 32 * 64 * 3;
        if (it >= NIT) return false;
        unsigned char* ws = p->ws; const float* w_in = p->in[3]; int r = it; bool found = false;
        TJOB(w_in, DIN, 2048, 6144, 2048, (bf16_t*)(ws + OFF_WZ), 0, 0)
        TJOB(w_in, DIN, 2048, 9248, 2048, (bf16_t*)(ws + OFF_WGA), 0, 0)
        TJOB(p->in[8], 256, 256, 0, 256, (bf16_t*)(ws + OFF_WPOOL), 0, 0)
        TJOB(p->in[8] + 65536, 256, 256, 0, 256, (bf16_t*)(ws + OFF_WPOOL), 256, 0)
        TJOB(p->in[8] + 2 * 65536, 256, 256, 0, 256, (bf16_t*)(ws + OFF_WPOOL), 512, 0)
        TJOB(p->in[8] + 3 * 65536, 256, 256, 0, 256, (bf16_t*)(ws + OFF_WPOOL), 768, 0)
        TJOB(p->in[10], 2048, 2048, 0, 2048, (bf16_t*)(ws + OFF_WA), 0, 0)
        TJOB(p->in[11], 2048, 1024, 0, 2048, (bf16_t*)(ws + OFF_WB), 0, 0)
        TJOB(p->in[12], 2048, 2048, 0, 2048, (bf16_t*)(ws + OFF_WMIX), 0, 0)
        TJOB(p->in[16], 2048, 2048, 0, 2048, (bf16_t*)(ws + OFF_WXQ), 0, 0)
        TJOB(p->in[18], 2048, 2048, 0, 2048, (bf16_t*)(ws + OFF_WXO), 0, 0)
        return found;
    }
};
struct LookupLate {
    const Params* p;
    __device__ __forceinline__ bool operator()(int it, TDesc& d) const {
        if (it >= 86 * 64 + 32 * 344) return false;
        unsigned char* ws = p->ws; int r = it; bool found = false;
        TJOB(p->in[24], 2048, 5504, 0, 2048, (bf16_t*)(ws + OFF_WDOWN), 0, 0)
        TJOB(p->in[21], 11008, 2048, 0, 11008, (bf16_t*)(ws + OFF_WUP), 0, 1)
        return found;
    }
};
template <class LK>
__device__ __forceinline__ void transpose_stream(const LK& lk, int first, int stride, LAS float* scr, int lane) {
    TDesc cur, nxt; f32x4 tc[8], tn[8];
    int it = first;
    bool hc = lk(it, cur);
    if (hc) t_load(cur, tc, lane);
    while (hc) {
        const bool hn = lk(it + stride, nxt);
        if (hn) t_load(nxt, tn, lane);
        t_finish(cur, tc, scr, lane);
        cur = nxt; hc = hn; it += stride;
#pragma unroll
        for (int i = 0; i < 8; ++i) tc[i] = tn[i];
    }
}

__device__ __forceinline__ void rms_row_to_bf16(const float* xrow, const float* w, bf16_t* orow, int lane) {
    f32x4 v[8]; float ss = 0.f;
#pragma unroll
    for (int j = 0; j < 8; ++j) { v[j] = *(const f32x4*)(xrow + 4 * lane + 256 * j); ss += (v[j][0] * v[j][0] + v[j][1] * v[j][1]) + (v[j][2] * v[j][2] + v[j][3] * v[j][3]); }
    const float r = rsqrtf(wave_sum(ss) * (1.0f / D) + EPS);
#pragma unroll
    for (int j = 0; j < 8; ++j) { const f32x4 g = *(const f32x4*)(w + 4 * lane + 256 * j); const f32x4 y = v[j] * r * g;
        u32x2 o; o.x = cvt_pk_bf16(y[0], y[1]); o.y = cvt_pk_bf16(y[2], y[3]); *(u32x2*)(orow + 4 * lane + 256 * j) = o; }
}

__device__ __forceinline__ void phase_convert0(const Params& p, LAS unsigned char* lds, int bid, int nb) {
    const int tid = threadIdx.x, lane = tid & 63, wid = tid >> 6;
    LAS float* scr = (LAS float*)(lds + wid * 8448);
    const int gw = bid * 8 + wid, ngw = nb * 8;
    unsigned char* ws = p.ws;
    { Lookup0 lk; lk.p = &p; transpose_stream(lk, gw, ngw, scr, lane); }
    { u32x4* z = (u32x4*)(ws + OFF_W0 + (size_t)6176 * 4096); const int nz = 224 * 4096 / 16;
      for (int i = bid * 512 + tid; i < nz; i += nb * 512) z[i] = (u32x4){0u, 0u, 0u, 0u}; }
    {
        f32x4 vc[8], vn[8];
        int row = gw;
#define RMS_SRC(r_) ((r_) < T ? p.in[0] + (size_t)(r_) * D : p.in[1] + (size_t)((r_) - T) * D)
        if (row < T + 512) {
#pragma unroll
            for (int j = 0; j < 8; ++j) vc[j] = *(const f32x4*)(RMS_SRC(row) + 4 * lane + 256 * j);
        }
        for (; row < T + 512; row += ngw) {
            const int nrow = row + ngw;
            if (nrow < T + 512) {
#pragma unroll
                for (int j = 0; j < 8; ++j) vn[j] = *(const f32x4*)(RMS_SRC(nrow) + 4 * lane + 256 * j);
            }
            const float* wv = row < T ? p.in[2] : p.in[15];
            bf16_t* orow = row < T ? (bf16_t*)p.out + (size_t)row * D : (bf16_t*)(ws + OFF_M) + (size_t)(row - T) * D;
            float ss = 0.f;
#pragma unroll
            for (int j = 0; j < 8; ++j) ss += (vc[j][0] * vc[j][0] + vc[j][1] * vc[j][1]) + (vc[j][2] * vc[j][2] + vc[j][3] * vc[j][3]);
            const float r = rsqrtf(wave_sum(ss) * (1.0f / D) + EPS);
#pragma unroll
            for (int j = 0; j < 8; ++j) { const f32x4 g = *(const f32x4*)(wv + 4 * lane + 256 * j); const f32x4 yv = vc[j] * r * g;
                u32x2 o; o.x = cvt_pk_bf16(yv[0], yv[1]); o.y = cvt_pk_bf16(yv[2], yv[3]); *(u32x2*)(orow + 4 * lane + 256 * j) = o; }
#pragma unroll
            for (int j = 0; j < 8; ++j) vc[j] = vn[j];
        }
#undef RMS_SRC
    }
}
__device__ __forceinline__ void phase_convert_late(const Params& p, LAS unsigned char* lds, int bid, int nb) {
    const int tid = threadIdx.x, lane = tid & 63, wid = tid >> 6;
    LAS float* scr = (LAS float*)(lds + wid * 8448);
    const int gw = bid * 8 + wid, ngw = nb * 8;
    { LookupLate lk; lk.p = &p; transpose_stream(lk, gw, ngw, scr, lane); }
}

__device__ __forceinline__ void phase_rows(const bf16_t* y, const float* xin32, const bf16_t* xin16, float* xout32, bf16_t* xout16, const float* wpost, const float* wpre, bf16_t* hout, int gw, int ngw, int lane) {
    u32x2 yc[8], yn[8]; f32x4 xc[8], xn[8];
    int row = gw;
#define ROWS_LOAD(yv, xv, r_) do { _Pragma("unroll") for (int j = 0; j < 8; ++j) { yv[j] = *(const u32x2*)(y + (size_t)(r_) * D + 4 * lane + 256 * j); \
        if (xin32) xv[j] = *(const f32x4*)(xin32 + (size_t)(r_) * D + 4 * lane + 256 * j); \
        else { const u32x2 xb = *(const u32x2*)(xin16 + (size_t)(r_) * D + 4 * lane + 256 * j); xv[j] = (f32x4){lo_bf(xb.x), hi_bf(xb.x), lo_bf(xb.y), hi_bf(xb.y)}; } } } while (0)
    if (row < T) ROWS_LOAD(yc, xc, row);
    for (; row < T; row += ngw) {
        const int nrow = row + ngw;
        if (nrow < T) ROWS_LOAD(yn, xn, nrow);
        f32x4 v[8]; float ss = 0.f;
#pragma unroll
        for (int j = 0; j < 8; ++j) { v[j] = (f32x4){lo_bf(yc[j].x), hi_bf(yc[j].x), lo_bf(yc[j].y), hi_bf(yc[j].y)}; ss += (v[j][0] * v[j][0] + v[j][1] * v[j][1]) + (v[j][2] * v[j][2] + v[j][3] * v[j][3]); }
        const float r = rsqrtf(wave_sum(ss) * (1.0f / D) + EPS);
        float s2 = 0.f;
#pragma unroll
        for (int j = 0; j < 8; ++j) { const f32x4 g = *(const f32x4*)(wpost + 4 * lane + 256 * j);
            v[j] = xc[j] + v[j] * r * g;
            if (xout32) *(f32x4*)(xout32 + (size_t)row * D + 4 * lane + 256 * j) = v[j];
            else { u32x2 o; o.x = cvt_pk_bf16(v[j][0], v[j][1]); o.y = cvt_pk_bf16(v[j][2], v[j][3]); *(u32x2*)(xout16 + (size_t)row * D + 4 * lane + 256 * j) = o; }
            s2 += (v[j][0] * v[j][0] + v[j][1] * v[j][1]) + (v[j][2] * v[j][2] + v[j][3] * v[j][3]); }
        if (hout) {
            const float r2 = rsqrtf(wave_sum(s2) * (1.0f / D) + EPS);
#pragma unroll
            for (int j = 0; j < 8; ++j) { const f32x4 g = *(const f32x4*)(wpre + 4 * lane + 256 * j); const f32x4 yv = v[j] * r2 * g;
                u32x2 o; o.x = cvt_pk_bf16(yv[0], yv[1]); o.y = cvt_pk_bf16(yv[2], yv[3]); *(u32x2*)(hout + (size_t)row * D + 4 * lane + 256 * j) = o; }
        }
#pragma unroll
        for (int j = 0; j < 8; ++j) { yc[j] = yn[j]; xc[j] = xn[j]; }
    }
#undef ROWS_LOAD
}

__device__ __forceinline__ void phase_pooldiff_tile(const Params& p, int g, int pm) {
    const bf16_t* src = (const bf16_t*)p.out + (size_t)T * D + (size_t)T * 1024;
    bf16_t* dst = (bf16_t*)p.out + (size_t)T * D;
    const int win = 2 << g;
    for (int task = threadIdx.x; task < 256 * 32; task += 512) {
        const int t = pm * 256 + (task >> 5), c8 = g * 256 + (task & 31) * 8, pos = t & (SEQ - 1);
        const int cnt = (pos + 1) < win ? (pos + 1) : win;
        float s[8] = {0.f, 0.f, 0.f, 0.f, 0.f, 0.f, 0.f, 0.f}; float c0[8];
        u32x4 wv[16];
#pragma unroll
        for (int k = 0; k < 16; ++k) wv[k] = (k < cnt) ? *(const u32x4*)(src + (size_t)(t - k) * 1024 + c8) : (u32x4){0u, 0u, 0u, 0u};
#pragma unroll
        for (int k = 0; k < 16; ++k) { const u32x4 v = wv[k];
            const float f[8] = {lo_bf(v.x), hi_bf(v.x), lo_bf(v.y), hi_bf(v.y), lo_bf(v.z), hi_bf(v.z), lo_bf(v.w), hi_bf(v.w)};
#pragma unroll
            for (int e = 0; e < 8; ++e) { s[e] += f[e]; if (k == 0) c0[e] = f[e]; } }
        const float inv = 1.0f / (float)cnt;
        u32x4 o; o.x = cvt_pk_bf16(s[0] * inv - c0[0], s[1] * inv - c0[1]); o.y = cvt_pk_bf16(s[2] * inv - c0[2], s[3] * inv - c0[3]);
        o.z = cvt_pk_bf16(s[4] * inv - c0[4], s[5] * inv - c0[5]); o.w = cvt_pk_bf16(s[6] * inv - c0[6], s[7] * inv - c0[7]);
        *(u32x4*)(dst + (size_t)t * 1024 + c8) = o;
    }
}

__device__ __forceinline__ void phase_prep(const Params& p, LAS unsigned char* lds, int bid, int nb) {
    const int tid = threadIdx.x, lane = tid & 63, wid = tid >> 6;
    LAS bf16_t* raw = (LAS bf16_t*)lds;
    LAS bf16_t* qs = (LAS bf16_t*)(lds + 51456);
    LAS bf16_t* ks = qs + 64 * 136;
    LAS bf16_t* vs = ks + 64 * 136;
    LAS bf16_t* M0 = (LAS bf16_t*)lds; LAS bf16_t* M1 = M0 + 4608; LAS bf16_t* M2 = M0 + 2 * 4608; LAS bf16_t* M3 = M0 + 3 * 4608; LAS bf16_t* M4 = M0 + 4 * 4608;
    LAS bf16_t* M5 = (LAS bf16_t*)(lds + 103680); LAS bf16_t* M6 = (LAS bf16_t*)(lds + 127232); LAS bf16_t* M7 = (LAS bf16_t*)(lds + 136448);
    LAS float* Gs = (LAS float*)(lds + 120064);
    LAS float* cwl = (LAS float*)(lds + 121088);
    bf16_t* prep = (bf16_t*)(p.ws + OFF_PREP);
    const float* ab = (const float*)(p.ws + OFF_AB);
    float* cd = (float*)(p.ws + OFF_CD);
    const float* convw = p.in[4];
    u32x4 pf[7]; f32x4 pfc = (f32x4){0.f, 0.f, 0.f, 0.f}; float pfa = 0.f, pfb = 0.f;
    const int cty = tid >> 7, cj = (tid & 127) >> 5, cd4 = (tid & 31) * 4;
    {
#pragma unroll
        for (int k = 0; k < 7; ++k) { const int v = tid + 512 * k; if (v < 3216) pf[k] = ((const u32x4*)(prep + (size_t)bid * SLOT))[v]; }
        const int bh0 = bid >> 7, n0 = bid & 127, hh0 = bh0 & 15;
        if (tid < 384) pfc = *(const f32x4*)(convw + cj * 6144 + cty * 2048 + hh0 * 128 + cd4);
        if (tid < 64) { const int t = (bh0 >> 4) * SEQ + n0 * 64 + tid; pfb = ab[(size_t)t * 32 + hh0]; pfa = ab[(size_t)t * 32 + 16 + hh0]; }
    }
    for (int item = bid; item < 4096; item += nb) {
        const int bh = item >> 7, n = item & 127, b = bh >> 4, hh = bh & 15;
        bf16_t* slot = prep + (size_t)item * SLOT;
#pragma unroll
        for (int k = 0; k < 7; ++k) { const int v = tid + 512 * k; if (v < 3216) ((LAS u32x4*)raw)[v] = pf[k]; }
        if (tid < 384) *(LAS f32x4*)(cwl + (cty * 4 + cj) * 128 + cd4) = pfc;
        if (tid < 64) {
            const float braw = pfb, araw = pfa;
            const float xx = araw + p.in[6][hh];
            const float sp = fmaxf(xx, 0.f) + log1pf(__expf(-fabsf(xx)));
            float G = -__expf(p.in[5][hh]) * sp;
#pragma unroll
            for (int o = 1; o < 64; o <<= 1) { const float t2 = __shfl_up(G, o); if (lane >= o) G += t2; }
            const float Gl = __shfl(G, 63);
            Gs[tid] = G; Gs[64 + tid] = sigmoid_f(braw); Gs[128 + tid] = __expf(G); Gs[192 + tid] = __expf(Gl - G);
            if (tid == 63) cd[item] = __expf(G);
        }
        LDS_BARRIER();
#pragma unroll 1
        for (int it = 0; it < 6; ++it) {
            const int ty = it >> 1, i = (tid >> 4) + 32 * (it & 1), d0 = (tid & 15) * 8;
            float a[8] = {0.f, 0.f, 0.f, 0.f, 0.f, 0.f, 0.f, 0.f};
            u32x4 rvv[4]; f32x4 cc0[4], cc1[4];
#pragma unroll
            for (int j = 0; j < 4; ++j) { rvv[j] = *(const LAS u32x4*)(raw + ty * RAWT + (i + j) * 128 + d0); const LAS float* cwp = cwl + (ty * 4 + j) * 128 + d0; cc0[j] = *(const LAS f32x4*)cwp; cc1[j] = *(const LAS f32x4*)(cwp + 4); }
            LDS_WAIT();
#pragma unroll
            for (int j = 0; j < 4; ++j) {
                if (n > 0 || i + j >= 3) {
                    const u32x4 rv = rvv[j]; const f32x4 c0 = cc0[j], c1 = cc1[j];
                    a[0] += c0[0] * lo_bf(rv.x); a[1] += c0[1] * hi_bf(rv.x); a[2] += c0[2] * lo_bf(rv.y); a[3] += c0[3] * hi_bf(rv.y);
                    a[4] += c1[0] * lo_bf(rv.z); a[5] += c1[1] * hi_bf(rv.z); a[6] += c1[2] * lo_bf(rv.w); a[7] += c1[3] * hi_bf(rv.w);
                }
            }
            float ss = 0.f;
#pragma unroll
            for (int e = 0; e < 8; ++e) { a[e] = silu_f(a[e]); ss += a[e] * a[e]; }
            if (ty < 2) {
                ss = dpp_red16(ss);
                float r = rsqrtf(ss + EPS); if (ty == 0) r *= 0.08838834764831845f;
#pragma unroll
                for (int e = 0; e < 8; ++e) a[e] *= r;
            }
            LAS bf16_t* dstp = (ty == 0 ? qs : (ty == 1 ? ks : vs)) + i * 136 + d0;
            u32x4 o; o.x = cvt_pk_bf16(a[0], a[1]); o.y = cvt_pk_bf16(a[2], a[3]); o.z = cvt_pk_bf16(a[4], a[5]); o.w = cvt_pk_bf16(a[6], a[7]);
            *(LAS u32x4*)dstp = o;
        }
        LDS_BARRIER();
        if (item + nb < 4096) {
#pragma unroll
            for (int k = 0; k < 7; ++k) { const int v = tid + 512 * k; if (v < 3216) pf[k] = ((const u32x4*)(prep + (size_t)(item + nb) * SLOT))[v]; }
            const int it2 = item + nb, bh2 = it2 >> 7, n2 = it2 & 127, hh2 = bh2 & 15;
            if (tid < 384) pfc = *(const f32x4*)(convw + cj * 6144 + cty * 2048 + hh2 * 128 + cd4);
            if (tid < 64) { const int t = (bh2 >> 4) * SEQ + n2 * 64 + tid; pfb = ab[(size_t)t * 32 + hh2]; pfa = ab[(size_t)t * 32 + 16 + hh2]; }
        }
        {
            const int pr = wid >> 2, rt = wid & 3, fr = lane & 15, fq = lane >> 4;
            const LAS bf16_t* Asrc = pr ? qs : ks;
            bf16x8 af[4];
#pragma unroll
            for (int kq = 0; kq < 4; ++kq) af[kq] = *(const LAS bf16x8*)(Asrc + (rt * 16 + fr) * 136 + kq * 32 + fq * 8);
            const int i = rt * 16 + fr; const float Gi = Gs[i], bi = Gs[64 + i];
#pragma unroll
            for (int ct = 0; ct < 4; ++ct) {
                f32x4 d = (f32x4){0.f, 0.f, 0.f, 0.f};
#pragma unroll
                for (int kq = 0; kq < 4; ++kq) { const bf16x8 bfr = *(const LAS bf16x8*)(ks + (ct * 16 + fr) * 136 + kq * 32 + fq * 8); d = __builtin_amdgcn_mfma_f32_16x16x32_bf16(bfr, af[kq], d, 0, 0, 0); }
                const int j0 = ct * 16 + fq * 4;
                f32x4 o;
#pragma unroll
                for (int jj = 0; jj < 4; ++jj) { const int j = j0 + jj; const float dec = __expf(fminf(Gi - Gs[j], 0.f));
                    o[jj] = pr ? ((i >= j) ? dec * d[jj] : 0.f) : ((i > j) ? bi * dec * d[jj] : 0.f); }
                if (pr) { u32x2 w; w.x = cvt_pk_bf16(o[0], o[1]); w.y = cvt_pk_bf16(o[2], o[3]); *(u32x2*)(slot + 32768 + i * 64 + j0) = w; }
                else {
                    u32x2 w; w.x = cvt_pk_bf16(o[0], o[1]); w.y = cvt_pk_bf16(o[2], o[3]);
                    *(LAS u32x2*)(M0 + i * 72 + j0) = w;
                    u32x2 pw; pw.x = cvt_pk_bf16((i == j0 ? 1.f : 0.f) - o[0], (i == j0 + 1 ? 1.f : 0.f) - o[1]);
                    pw.y = cvt_pk_bf16((i == j0 + 2 ? 1.f : 0.f) - o[2], (i == j0 + 3 ? 1.f : 0.f) - o[3]);
                    *(LAS u32x2*)(M6 + i * 72 + j0) = pw;
                    M1[(j0 + 0) * 72 + i] = (bf16_t)(w.x & 0xffffu); M1[(j0 + 1) * 72 + i] = (bf16_t)(w.x >> 16);
                    M1[(j0 + 2) * 72 + i] = (bf16_t)(w.y & 0xffffu); M1[(j0 + 3) * 72 + i] = (bf16_t)(w.y >> 16);
                }
            }
        }
        LDS_BARRIER();
        {
            const int fr = lane & 15, fq = lane >> 4;
            {
#pragma unroll
                for (int tt = 0; tt < 2; ++tt) {
                    const int t = 2 * wid + tt, ti = t >> 2, tj = t & 3;
                    f32x4 acc = (f32x4){0.f, 0.f, 0.f, 0.f};
#pragma unroll
                    for (int kq = 0; kq < 2; ++kq) { const bf16x8 av = *(const LAS bf16x8*)(M0 + (ti * 16 + fr) * 72 + kq * 32 + fq * 8); const bf16x8 bv = *(const LAS bf16x8*)(M1 + (tj * 16 + fr) * 72 + kq * 32 + fq * 8);
                        acc = __builtin_amdgcn_mfma_f32_16x16x32_bf16(av, bv, acc, 0, 0, 0); }
                    u32x2 pk; pk.x = cvt_pk_bf16(acc[0], acc[1]); pk.y = cvt_pk_bf16(acc[2], acc[3]);
                    *(LAS u32x2*)(M3 + (tj * 16 + fr) * 72 + ti * 16 + fq * 4) = pk;
                    M2[(ti * 16 + fq * 4 + 0) * 72 + tj * 16 + fr] = (bf16_t)(pk.x & 0xffffu); M2[(ti * 16 + fq * 4 + 1) * 72 + tj * 16 + fr] = (bf16_t)(pk.x >> 16);
                    M2[(ti * 16 + fq * 4 + 2) * 72 + tj * 16 + fr] = (bf16_t)(pk.y & 0xffffu); M2[(ti * 16 + fq * 4 + 3) * 72 + tj * 16 + fr] = (bf16_t)(pk.y >> 16);
                }
            }
            LDS_BARRIER();
#pragma unroll 1
            for (int k = 1; k <= 5; ++k) {
                LAS bf16_t* Sc = (k & 1) ? M2 : M4; LAS bf16_t* ScT = (k & 1) ? M3 : M5; LAS bf16_t* Sn = (k & 1) ? M4 : M2; LAS bf16_t* SnT = (k & 1) ? M5 : M3;
                LAS bf16_t* Pc = (k & 1) ? M6 : M7; LAS bf16_t* Pn = (k & 1) ? M7 : M6;
                const int ti = wid & 3;
                if (wid < 4) {
                    if (k < 5) {
#pragma unroll 1
                        for (int tj = 0; tj < 4; ++tj) {
                            f32x4 acc = (f32x4){0.f, 0.f, 0.f, 0.f};
#pragma unroll
                            for (int kq = 0; kq < 2; ++kq) { const bf16x8 av = *(const LAS bf16x8*)(Sc + (ti * 16 + fr) * 72 + kq * 32 + fq * 8); const bf16x8 bv = *(const LAS bf16x8*)(ScT + (tj * 16 + fr) * 72 + kq * 32 + fq * 8);
                                acc = __builtin_amdgcn_mfma_f32_16x16x32_bf16(av, bv, acc, 0, 0, 0); }
                            u32x2 pk; pk.x = cvt_pk_bf16(acc[0], acc[1]); pk.y = cvt_pk_bf16(acc[2], acc[3]);
                            *(LAS u32x2*)(SnT + (tj * 16 + fr) * 72 + ti * 16 + fq * 4) = pk;
                            Sn[(ti * 16 + fq * 4 + 0) * 72 + tj * 16 + fr] = (bf16_t)(pk.x & 0xffffu); Sn[(ti * 16 + fq * 4 + 1) * 72 + tj * 16 + fr] = (bf16_t)(pk.x >> 16);
                            Sn[(ti * 16 + fq * 4 + 2) * 72 + tj * 16 + fr] = (bf16_t)(pk.y & 0xffffu); Sn[(ti * 16 + fq * 4 + 3) * 72 + tj * 16 + fr] = (bf16_t)(pk.y >> 16);
                        }
                    }
                } else {
#pragma unroll 1
                    for (int tj = 0; tj < 4; ++tj) {
                        f32x4 acc;
#pragma unroll
                        for (int jj = 0; jj < 4; ++jj) acc[jj] = bf2f(Pc[(ti * 16 + fq * 4 + jj) * 72 + tj * 16 + fr]);
#pragma unroll
                        for (int kq = 0; kq < 2; ++kq) { const bf16x8 av = *(const LAS bf16x8*)(Pc + (ti * 16 + fr) * 72 + kq * 32 + fq * 8); const bf16x8 bv = *(const LAS bf16x8*)(ScT + (tj * 16 + fr) * 72 + kq * 32 + fq * 8);
                            acc = __builtin_amdgcn_mfma_f32_16x16x32_bf16(av, bv, acc, 0, 0, 0); }
                        const unsigned p01 = cvt_pk_bf16(acc[0], acc[1]), p23 = cvt_pk_bf16(acc[2], acc[3]);
                        Pn[(ti * 16 + fq * 4 + 0) * 72 + tj * 16 + fr] = (bf16_t)(p01 & 0xffffu); Pn[(ti * 16 + fq * 4 + 1) * 72 + tj * 16 + fr] = (bf16_t)(p01 >> 16);
                        Pn[(ti * 16 + fq * 4 + 2) * 72 + tj * 16 + fr] = (bf16_t)(p23 & 0xffffu); Pn[(ti * 16 + fq * 4 + 3) * 72 + tj * 16 + fr] = (bf16_t)(p23 >> 16);
                    }
                }
                LDS_BARRIER();
            }
            {
                const LAS bf16_t* Tinv = M7;
                const int ct = wid;
                bf16x8 Xv[2], Xk[2];
#pragma unroll
                for (int kq = 0; kq < 2; ++kq) {
                    const int jb = kq * 32 + fq * 8;
                    const f32x4 b0 = *(const LAS f32x4*)(Gs + 64 + jb), b1 = *(const LAS f32x4*)(Gs + 64 + jb + 4), e0 = *(const LAS f32x4*)(Gs + 128 + jb), e1 = *(const LAS f32x4*)(Gs + 128 + jb + 4);
                    float fv[8], fk[8];
#pragma unroll
                    for (int e = 0; e < 8; ++e) { const float be = e < 4 ? b0[e & 3] : b1[e & 3], ee = e < 4 ? e0[e & 3] : e1[e & 3];
                        fv[e] = bf2f(vs[(jb + e) * 136 + ct * 16 + fr]) * be; fk[e] = bf2f(ks[(jb + e) * 136 + ct * 16 + fr]) * be * ee; }
                    u32x4 pv, pk2; pv.x = cvt_pk_bf16(fv[0], fv[1]); pv.y = cvt_pk_bf16(fv[2], fv[3]); pv.z = cvt_pk_bf16(fv[4], fv[5]); pv.w = cvt_pk_bf16(fv[6], fv[7]);
                    pk2.x = cvt_pk_bf16(fk[0], fk[1]); pk2.y = cvt_pk_bf16(fk[2], fk[3]); pk2.z = cvt_pk_bf16(fk[4], fk[5]); pk2.w = cvt_pk_bf16(fk[6], fk[7]);
                    Xv[kq] = __builtin_bit_cast(bf16x8, pv); Xk[kq] = __builtin_bit_cast(bf16x8, pk2);
                }
#pragma unroll 1
                for (int ti = 0; ti < 4; ++ti) {
                    f32x4 du = (f32x4){0.f, 0.f, 0.f, 0.f}, dk = (f32x4){0.f, 0.f, 0.f, 0.f};
#pragma unroll
                    for (int kq = 0; kq < 2; ++kq) { const bf16x8 ty = *(const LAS bf16x8*)(Tinv + (ti * 16 + fr) * 72 + kq * 32 + fq * 8);
                        du = __builtin_amdgcn_mfma_f32_16x16x32_bf16(Xv[kq], ty, du, 0, 0, 0); dk = __builtin_amdgcn_mfma_f32_16x16x32_bf16(Xk[kq], ty, dk, 0, 0, 0); }
                    const int i = ti * 16 + fr, c0 = ct * 16 + fq * 4;
                    u32x2 wu, wk2; wu.x = cvt_pk_bf16(du[0], du[1]); wu.y = cvt_pk_bf16(du[2], du[3]); wk2.x = cvt_pk_bf16(dk[0], dk[1]); wk2.y = cvt_pk_bf16(dk[2], dk[3]);
                    *(u32x2*)(slot + i * 128 + c0) = wu; *(u32x2*)(slot + 8192 + i * 128 + c0) = wk2;
                }
            }
            for (int v = tid; v < 1024; v += 512) { const int i = v >> 4, d0 = (v & 15) * 8; const u32x4 q = *(const LAS u32x4*)(qs + i * 136 + d0); const float e = Gs[128 + i];
                u32x4 o; o.x = cvt_pk_bf16(lo_bf(q.x) * e, hi_bf(q.x) * e); o.y = cvt_pk_bf16(lo_bf(q.y) * e, hi_bf(q.y) * e); o.z = cvt_pk_bf16(lo_bf(q.z) * e, hi_bf(q.z) * e); o.w = cvt_pk_bf16(lo_bf(q.w) * e, hi_bf(q.w) * e);
                *(u32x4*)(slot + 16384 + i * 128 + d0) = o; }
            for (int v = tid; v < 1024; v += 512) { const int d = v >> 3, i0 = (v & 7) * 8; float f[8];
#pragma unroll
                for (int e = 0; e < 8; ++e) f[e] = bf2f(ks[(i0 + e) * 136 + d]) * Gs[192 + i0 + e];
                u32x4 o; o.x = cvt_pk_bf16(f[0], f[1]); o.y = cvt_pk_bf16(f[2], f[3]); o.z = cvt_pk_bf16(f[4], f[5]); o.w = cvt_pk_bf16(f[6], f[7]);
                *(u32x4*)(slot + 24576 + d * 64 + i0) = o; }
        }
        LDS_BARRIER();
    }
}

__device__ __forceinline__ void phase_scan(const Params& p, LAS unsigned char* lds, int bid) {
    const int tid = threadIdx.x, lane = tid & 63, w = __builtin_amdgcn_readfirstlane(tid >> 6), fr = lane & 15, fq = lane >> 4;
    const int kx = bid >> 3, h32 = (bid & 7) + 8 * (kx >> 3), s = kx & 7, b = h32 >> 4, hh = h32 & 15;
    LAS bf16_t* Wk = (LAS bf16_t*)lds;
    LAS bf16_t* Qd = Wk + 64 * 136;
    LAS bf16_t* KdT = Qd + 64 * 136;
    LAS bf16_t* At = KdT + 128 * 72;
    LAS bf16_t* Uv = At + 64 * 72;
    LAS bf16_t* ST = (LAS bf16_t*)(lds + 64512);
    LAS bf16_t* UT = (LAS bf16_t*)(lds + 68864);
    LAS bf16_t* Ot = (LAS bf16_t*)(lds + 71168);
    const bf16_t* prep = (const bf16_t*)(p.ws + OFF_PREP) + (size_t)h32 * 128 * SLOT;
    const float* cd = (const float*)(p.ws + OFF_CD) + h32 * 128;
    bf16_t* on = (bf16_t*)p.out + (size_t)T * D;
    float* ssq = (float*)(p.ws + OFF_SSQ);
    const int rt = w & 3, which = w >> 2;
    f32x4 Sacc = (f32x4){0.f, 0.f, 0.f, 0.f};
    for (int i = tid; i < 16 * 136 / 2; i += 512) ((LAS unsigned*)ST)[i] = 0u;
    const int urow = tid >> 1, uhalf = tid & 1;
    u32x4 st[7], stu = (u32x4){0u, 0u, 0u, 0u};
#pragma unroll
    for (int k = 0; k < 7; ++k) st[k] = ((const u32x4*)prep)[1024 + tid + 512 * k];
    if (tid < 128) stu = ((const u32x4*)prep)[urow * 16 + s * 2 + uhalf];
    for (int n = 0; n < 128; ++n) {
        LDS_BARRIER();
        if (n > 0 && tid < 128) *(u32x4*)(on + (size_t)(b * SEQ + (n - 1) * 64 + urow) * D + hh * 128 + s * 16 + uhalf * 8) = *(const LAS u32x4*)(Ot + urow * 16 + uhalf * 8);
#pragma unroll
        for (int k = 0; k < 7; ++k) {
            const int v = tid + 512 * k;
            LAS bf16_t* dp;
            if (k < 2) dp = Wk + (v >> 4) * 136 + (v & 15) * 8;
            else if (k < 4) dp = Qd + ((v - 1024) >> 4) * 136 + (v & 15) * 8;
            else if (k < 6) dp = KdT + ((v - 2048) >> 3) * 72 + (v & 7) * 8;
            else dp = At + ((v - 3072) >> 3) * 72 + (v & 7) * 8;
            *(LAS u32x4*)dp = st[k];
        }
        if (tid < 128) *(LAS u32x4*)(Uv + urow * 16 + uhalf * 8) = stu;
        const float cdv = cd[n];
        LDS_BARRIER();
        if (n + 1 < 128) {
            const u32x4* nx = (const u32x4*)(prep + (size_t)(n + 1) * SLOT);
#pragma unroll
            for (int k = 0; k < 7; ++k) st[k] = nx[1024 + tid + 512 * k];
            if (tid < 128) stu = nx[urow * 16 + s * 2 + uhalf];
        }
        f32x4 X = (f32x4){0.f, 0.f, 0.f, 0.f};
        bf16x8 aK[2], aA[2];
        {
            const LAS bf16_t* Asrc = (which ? Qd : Wk) + (rt * 16 + fr) * 136 + fq * 8;
            bf16x8 bSv[4], av[4];
#pragma unroll
            for (int kq = 0; kq < 4; ++kq) { bSv[kq] = *(const LAS bf16x8*)(ST + fr * 136 + kq * 32 + fq * 8); av[kq] = *(const LAS bf16x8*)(Asrc + kq * 32); }
            float uvv[4];
#pragma unroll
            for (int jj = 0; jj < 4; ++jj) uvv[jj] = bf2f(Uv[(rt * 16 + fq * 4 + jj) * 16 + fr]);
#pragma unroll
            for (int kc = 0; kc < 2; ++kc) { aK[kc] = *(const LAS bf16x8*)(KdT + (w * 16 + fr) * 72 + kc * 32 + fq * 8); aA[kc] = *(const LAS bf16x8*)(At + (rt * 16 + fr) * 72 + kc * 32 + fq * 8); }
            LDS_WAIT();
#pragma unroll
            for (int kq = 0; kq < 4; ++kq) X = __builtin_amdgcn_mfma_f32_16x16x32_bf16(av[kq], bSv[kq], X, 0, 0, 0);
            if (which == 0) {
                u32x2 pk; pk.x = cvt_pk_bf16(uvv[0] - X[0], uvv[1] - X[1]); pk.y = cvt_pk_bf16(uvv[2] - X[2], uvv[3] - X[3]);
                *(LAS u32x2*)(UT + fr * 72 + rt * 16 + fq * 4) = pk;
            }
        }
        LDS_BARRIER();
        bf16x8 bU[2];
#pragma unroll
        for (int kc = 0; kc < 2; ++kc) bU[kc] = *(const LAS bf16x8*)(UT + fr * 72 + kc * 32 + fq * 8);
        LDS_WAIT();
        Sacc *= cdv;
#pragma unroll
        for (int kc = 0; kc < 2; ++kc) Sacc = __builtin_amdgcn_mfma_f32_16x16x32_bf16(aK[kc], bU[kc], Sacc, 0, 0, 0);
        if (which == 1) {
#pragma unroll
            for (int kc = 0; kc < 2; ++kc) X = __builtin_amdgcn_mfma_f32_16x16x32_bf16(aA[kc], bU[kc], X, 0, 0, 0);
            float sq[4];
#pragma unroll
            for (int jj = 0; jj < 4; ++jj) sq[jj] = dpp_red16(X[jj] * X[jj]);
            if (fr == 0) {
#pragma unroll
                for (int jj = 0; jj < 4; ++jj) ssq[(size_t)(b * SEQ + n * 64 + rt * 16 + fq * 4 + jj) * 128 + hh * 8 + s] = sq[jj];
            }
#pragma unroll
            for (int jj = 0; jj < 4; ++jj) Ot[(rt * 16 + fq * 4 + jj) * 16 + fr] = (bf16_t)(cvt_pk_bf16(X[jj], 0.f) & 0xffffu);
        }
        { u32x2 pk; pk.x = cvt_pk_bf16(Sacc[0], Sacc[1]); pk.y = cvt_pk_bf16(Sacc[2], Sacc[3]); *(LAS u32x2*)(ST + fr * 136 + w * 16 + fq * 4) = pk; }
    }
    LDS_BARRIER();
    if (tid < 128) *(u32x4*)(on + (size_t)(b * SEQ + 127 * 64 + urow) * D + hh * 128 + s * 16 + uhalf * 8) = *(const LAS u32x4*)(Ot + urow * 16 + uhalf * 8);
}


#define XB_TMO      128
#define XB_XCNT(j)  (256  + 64 * (j))
#define XB_XSUB(j)  (1280 + 64 * (j))
#define XB_XGEN(j)  (2304 + 64 * (j))
#define XB_TOP      3328
#define XB_TOPGEN   3392
#define XCD_BAR_WORDS 3456
#define XB_SPIN_CAP (1u << 18)
__device__ __forceinline__ unsigned xb_ld(unsigned* p)              { return __hip_atomic_load(p, __ATOMIC_RELAXED, __HIP_MEMORY_SCOPE_AGENT); }
__device__ __forceinline__ unsigned xb_add(unsigned* p, unsigned v) { return __hip_atomic_fetch_add(p, v, __ATOMIC_RELAXED, __HIP_MEMORY_SCOPE_AGENT); }
__device__ __forceinline__ unsigned xb_xcc_id() { return (unsigned)__builtin_amdgcn_s_getreg((3 << 11) | 20) & 0xFu; }
#define XB_SPIN(cond, bar) do { unsigned _sp = 0; while (cond) { __builtin_amdgcn_s_sleep(1); \
    if ((++_sp & 255u) == 0u) { if (xb_ld(&(bar)[XB_TMO])) break; if (_sp > XB_SPIN_CAP) { atomicAdd(&(bar)[XB_TMO], 1u); break; } } } } while (0)
struct XcdBarrier { unsigned* bar; unsigned x; volatile LAS unsigned* st; };
__device__ __forceinline__ XcdBarrier xcd_barrier_post(unsigned* bar, volatile LAS unsigned* st) {
    XcdBarrier b; b.bar = bar; b.x = xb_xcc_id(); b.st = st;
    if (threadIdx.x == 0) (void)xb_add(&bar[XB_XCNT(b.x)], 1u);
    return b;
}
__device__ __forceinline__ void xcd_barrier_complete(unsigned* bar, unsigned x, unsigned& nloc, unsigned& nx) {
    const unsigned G = gridDim.x * gridDim.y * gridDim.z;
    unsigned sum, cnt, mine, sp = 0u;
    for (;;) {
        sum = 0u; cnt = 0u; mine = 0u;
#pragma unroll
        for (unsigned j = 0; j < 16; ++j) { const unsigned c = xb_ld(&bar[XB_XCNT(j)]); sum += c; cnt += (c > 0u) ? 1u : 0u; mine = (j == x) ? c : mine; }
        if (sum == G) break;
        __builtin_amdgcn_s_sleep(1);
        if ((++sp & 255u) == 0u) { if (xb_ld(&bar[XB_TMO])) break; if (sp > XB_SPIN_CAP) { atomicAdd(&bar[XB_TMO], 1u); break; } }
    }
    nloc = mine > 0u ? mine : 1u; nx = cnt > 0u ? cnt : 1u;
}
__device__ __forceinline__ void xcd_barrier(const XcdBarrier& b) {
    asm volatile("s_waitcnt vmcnt(0)" ::: "memory");
    __syncthreads();
    if (threadIdx.x == 0) {
        unsigned* bar = b.bar;
        __builtin_amdgcn_s_waitcnt(0);
        unsigned nloc = b.st[0], nx = b.st[1];
        if (nloc == 0u) { xcd_barrier_complete(bar, b.x, nloc, nx); b.st[0] = nloc; b.st[1] = nx; }
        const unsigned old = xb_add(&bar[XB_XSUB(b.x)], 1u);
        const unsigned gen = old / nloc;
        if (old + 1u == (gen + 1u) * nloc) {
            __builtin_amdgcn_fence(__ATOMIC_RELEASE, "agent");
            asm volatile("s_waitcnt vmcnt(0)" ::: "memory");
            const unsigned og = xb_add(&bar[XB_TOP], 1u);
            const unsigned tg = og / nx;
            if (og + 1u == (tg + 1u) * nx) xb_add(&bar[XB_TOPGEN], 1u);
            else XB_SPIN(xb_ld(&bar[XB_TOPGEN]) == tg, bar);
            __builtin_amdgcn_fence(__ATOMIC_ACQUIRE, "agent");
            xb_add(&bar[XB_XGEN(b.x)], 1u);
            asm volatile("s_waitcnt vmcnt(0)" ::: "memory");
        } else {
            XB_SPIN(xb_ld(&bar[XB_XGEN(b.x)]) == gen, bar);
            __builtin_amdgcn_fence(__ATOMIC_ACQUIRE, "agent");
            asm volatile("s_waitcnt vmcnt(0)" ::: "memory");
        }
    }
    __syncthreads();
}

enum { ST_CONV0 = 0, ST_QKV, ST_PREP, ST_SCAN, ST_Z, ST_GA, ST_BA, ST_MIX, ST_ROW1, ST_XQ, ST_SM, ST_XO, ST_ROW2, ST_UP, ST_DOWN, ST_ROW3, ST_COUNT };
__host__ __device__ inline bool sync_after(int st) { return !(st == ST_Z); }

__device__ __forceinline__ void job_init(GJob& j, const void* A, int lda, const void* B, int ldb, int K, int nM, int nN, int bid, int nb) {
    j.A = (const char*)A; j.B = (const char*)B; j.sA1 = j.sA2 = j.sB1 = j.sB2 = 0; j.lda = lda; j.ldb = ldb; j.K = K; j.nM = nM; j.nN = nN; j.G1 = 1; j.G2 = 1;
    j.rstride = 256; j.orow0 = 0; j.oR1 = j.oR2 = j.oC1 = j.oC2 = 0; j.G = nb; j.c = bid; j.direct = 0;
}

#ifndef STEP_MASK
#define STEP_MASK 0xffffffffu
#endif
#define STEP_BEGIN(k) if (((STEP_MASK >> (k)) & 1u) && p.st_lo <= (k) && (k) < p.st_hi) {
#define STEP_END(k) if ((k) + 1 < p.st_hi && sync_after(k)) xcd_barrier(xb); }
#define GEMM_B(k, Aptr, lda_, Bptr, ldb_, K_, nM_, nN_, SETUP, Optr, ldc_, mode_, aux1_, aux2_, cs_) STEP_BEGIN(k) { GJob j; job_init(j, Aptr, lda_, Bptr, ldb_, K_, nM_, nN_, bid, nb); SETUP; \
    EpiB e; e.O = (bf16_t*)(Optr); e.ldc = ldc_; e.mode = mode_; e.aux1 = (const bf16_t*)(aux1_); e.aux2 = (const bf16_t*)(aux2_); e.cscale = cs_; e.ssq = (const float*)(ws + OFF_SSQ); e.gn = p.in[7]; pg8::gemm_phase<EpiB>(lds, j, e); } STEP_END(k)
#define GEMM_F(k, Aptr, lda_, Bptr, ldb_, K_, nM_, nN_, Cptr) STEP_BEGIN(k) { GJob j; job_init(j, Aptr, lda_, Bptr, ldb_, K_, nM_, nN_, bid, nb); \
    EpiF e; e.C = (float*)(Cptr); e.ldc = 2048; pg8::gemm_phase<EpiF>(lds, j, e); } STEP_END(k)

__global__ void __launch_bounds__(512, 2) mega(Params p) {
    extern __shared__ __attribute__((aligned(16))) unsigned char smem[];
    LAS unsigned char* lds = (LAS unsigned char*)smem;
    cg::grid_group grid = cg::this_grid();
    const int bid = blockIdx.x, nb = gridDim.x;
    unsigned char* const ws = p.ws;
    bf16_t* const Hb = (bf16_t*)p.out; bf16_t* const ON = (bf16_t*)p.out + (size_t)T * D;
    const float* const nullf = nullptr;
    volatile LAS unsigned* xbst = (volatile LAS unsigned*)(lds + LDS_BYTES - 16);
    if (threadIdx.x == 0) { xbst[0] = 0u; xbst[1] = 0u; xbst[2] = 0u; xbst[3] = 0u; }
    __syncthreads();
    XcdBarrier xb = xcd_barrier_post((unsigned*)(ws + OFF_BAR), xbst);
    if (p.st_hi > 1000) grid.sync();
    STEP_BEGIN(ST_CONV0) phase_convert0(p, lds, bid, nb); STEP_END(ST_CONV0)
    STEP_BEGIN(ST_QKV) {
        { GJob j; job_init(j, Hb, 4096, ws + OFF_W0, 4096, 2048, 64, 29, bid, nb); EpiQKV e; e.prep = (bf16_t*)(ws + OFF_PREP); e.ab = (float*)(ws + OFF_AB); e.poola = (bf16_t*)p.out + (size_t)T * D + (size_t)T * 1024; pg8::gemm_phase<EpiQKV>(lds, j, e); }
        EpiB e; e.mode = 0; e.aux1 = nullptr; e.aux2 = nullptr; e.cscale = nullptr; e.ssq = nullptr; e.gn = nullptr;
        { GJob j; job_init(j, ws + OFF_M, 4096, ws + OFF_WXKV, 4096, 2048, 2, 8, (bid + nb / 2) % nb, nb); e.O = (bf16_t*)(ws + OFF_KM); e.ldc = 2048; pg8::gemm_phase<EpiB>(lds, j, e); }
        { GJob j; job_init(j, ws + OFF_WXKV + (size_t)2048 * 4096, 4096, ws + OFF_M, 4096, 2048, 8, 2, (bid + 3 * nb / 4) % nb, nb); e.O = (bf16_t*)(ws + OFF_VT); e.ldc = 512; pg8::gemm_phase<EpiB>(lds, j, e); }
        { GJob j; job_init(j, Hb, 4096, ws + OFF_WGB, 4096, 2048, 64, 8, bid, nb); e.O = (bf16_t*)(ws + OFF_YB); e.ldc = 2048; e.mode = 5; pg8::gemm_phase<EpiB>(lds, j, e); }
        { const int frank = (bid >= 80 && bid < 128) ? bid - 80 : ((bid >= 144 && bid < 256) ? bid - 144 + 48 : -1);
          if (frank >= 0) { LookupDeferred lk; lk.p = &p; transpose_stream(lk, frank * 8 + (int)(threadIdx.x >> 6), 160 * 8, (LAS float*)(lds + (threadIdx.x >> 6) * 8448), (int)(threadIdx.x & 63)); } }
    } STEP_END(ST_QKV)
    STEP_BEGIN(ST_PREP) {
        phase_prep(p, lds, bid, nb);
        if (bid < 256) phase_pooldiff_tile(p, bid >> 6, bid & 63);
        asm volatile("s_waitcnt vmcnt(0)" ::: "memory"); __syncthreads();
        GJob j; job_init(j, ON, 2048, ws + OFF_WPOOL, 512, 256, 64, 1, bid, nb); j.direct = 1; j.G1 = 4; j.sA1 = 512; j.sB1 = 256 * 512; j.oC1 = 256;
        EpiB e; e.O = (bf16_t*)(ws + OFF_POOLA); e.ldc = 1024; e.mode = 4; e.aux1 = nullptr; e.aux2 = nullptr; e.cscale = p.in[9]; e.ssq = nullptr; e.gn = nullptr; pg8::gemm_phase<EpiB>(lds, j, e);
    } STEP_END(ST_PREP)
    STEP_BEGIN(ST_SCAN) {
        phase_scan(p, lds, bid);
        GJob j; job_init(j, ws + OFF_POOLA, 2048, ws + OFF_WB, 2048, 1024, 64, 8, bid, nb);
        EpiB e; e.O = (bf16_t*)(ws + OFF_YB); e.ldc = 2048; e.mode = 6; e.aux1 = (const bf16_t*)(ws + OFF_YB); e.aux2 = nullptr; e.cscale = nullptr; e.ssq = nullptr; e.gn = nullptr; pg8::gemm_phase<EpiB>(lds, j, e);
    } STEP_END(ST_SCAN)
    GEMM_B(ST_Z, Hb, 4096, ws + OFF_WZ, 4096, 2048, 64, 8, (void)0, ON, 2048, 1, ON, nullptr, nullf)
    GEMM_B(ST_GA, Hb, 4096, ws + OFF_WGA, 4096, 2048, 64, 8, (void)0, ws + OFF_YA, 2048, 5, nullptr, nullptr, nullf)
    GEMM_B(ST_BA, ON, 4096, ws + OFF_WA, 4096, 2048, 64, 8, (void)0, ws + OFF_YA, 2048, 7, ws + OFF_YA, ws + OFF_YB, nullf)
    GEMM_B(ST_MIX, ws + OFF_YA, 4096, ws + OFF_WMIX, 4096, 2048, 64, 8, (void)0, ws + OFF_Y, 2048, 0, nullptr, nullptr, nullf)
    STEP_BEGIN(ST_ROW1) phase_rows((const bf16_t*)(ws + OFF_Y), p.in[0], nullptr, nullptr, (bf16_t*)(ws + OFF_XB), p.in[13], p.in[14], (bf16_t*)(ws + OFF_H2), bid * 8 + (threadIdx.x >> 6), nb * 8, threadIdx.x & 63); phase_convert_late(p, lds, bid, nb); STEP_END(ST_ROW1)
    GEMM_B(ST_XQ, ws + OFF_H2, 4096, ws + OFF_WXQ, 4096, 2048, 64, 8, (void)0, ws + OFF_Q, 2048, 0, nullptr, nullptr, nullf)
    STEP_BEGIN(ST_SM) {
        { GJob j; job_init(j, ws + OFF_Q, 4096, ws + OFF_KM, 4096, 512, 32, 1, bid, nb); j.direct = 1; j.G1 = 2; j.G2 = 4; j.sA1 = (long)SEQ * 4096; j.sA2 = 1024; j.sB1 = 256 * 4096; j.sB2 = 1024; j.oR1 = 4 * SEQ; j.oR2 = SEQ;
          EpiSM e; e.P = (bf16_t*)(ws + OFF_P); pg8::gemm_phase<EpiSM>(lds, j, e); }
        { GJob j; job_init(j, ws + OFF_P, 512, ws + OFF_VT, 1024, 256, 32, 2, bid, nb); j.direct = 2; j.G1 = 2; j.G2 = 4; j.sA1 = (long)4 * SEQ * 512; j.sA2 = (long)SEQ * 512; j.sB1 = 512; j.sB2 = 512 * 1024; j.oR1 = SEQ; j.oC2 = 512;
          EpiB e; e.O = (bf16_t*)(ws + OFF_O); e.ldc = 2048; e.mode = 0; e.aux1 = nullptr; e.aux2 = nullptr; e.cscale = nullptr; e.ssq = nullptr; e.gn = nullptr; pg8::gemm_phase<EpiB>(lds, j, e); }
    } STEP_END(ST_SM)
    GEMM_B(ST_XO, ws + OFF_O, 4096, ws + OFF_WXO, 4096, 2048, 64, 8, (void)0, ws + OFF_Y, 2048, 0, nullptr, nullptr, nullf)
    STEP_BEGIN(ST_ROW2) phase_rows((const bf16_t*)(ws + OFF_Y), nullptr, (const bf16_t*)(ws + OFF_XB), nullptr, (bf16_t*)(ws + OFF_XB), p.in[19], p.in[20], (bf16_t*)(ws + OFF_H3), bid * 8 + (threadIdx.x >> 6), nb * 8, threadIdx.x & 63); STEP_END(ST_ROW2)
    STEP_BEGIN(ST_UP) { GJob j; job_init(j, ws + OFF_H3 - 2 * 4096, 4096, ws + OFF_WUP, 4096, 2048, 65, 43, bid, nb); j.rstride = 254; j.orow0 = -2;
        EpiCG e; e.act = (bf16_t*)(ws + OFF_ACT); e.cw = p.in[22]; e.cb = p.in[23]; pg8::gemm_phase<EpiCG>(lds, j, e); } STEP_END(ST_UP)
    GEMM_B(ST_DOWN, ws + OFF_ACT, 11008, ws + OFF_WDOWN, 11008, 5504, 64, 8, (void)0, ws + OFF_YDOWN, 2048, 0, nullptr, nullptr, nullf)
    STEP_BEGIN(ST_ROW3) phase_rows((const bf16_t*)(ws + OFF_YDOWN), nullptr, (const bf16_t*)(ws + OFF_XB), p.out, nullptr, p.in[25], nullptr, nullptr, bid * 8 + (threadIdx.x >> 6), nb * 8, threadIdx.x & 63); STEP_END(ST_ROW3)
#ifdef DBG_CK
    {
        unsigned* ckw = (unsigned*)(ws + 511 * MiB);
        grid.sync();
        if (bid == 0 && threadIdx.x == 0) __hip_atomic_store(ckw, 0u, __ATOMIC_RELAXED, __HIP_MEMORY_SCOPE_AGENT);
        grid.sync();
        const unsigned* reg = (const unsigned*)(ws + DBG_CK_OFF);
        unsigned s = 0;
        for (size_t i = (size_t)bid * 512 + threadIdx.x; i < (size_t)DBG_CK_WORDS; i += (size_t)nb * 512) {
            bool use = true;
#ifdef DBG_CK_RAWONLY
            { const size_t el = (2 * i) % SLOT; use = el < 3 * RAWT && (el % RAWT) >= 384; }
#endif
            if (use) s += reg[i] * (unsigned)(2 * i + 1);
        }
        atomicAdd(ckw, s);
        grid.sync();
        const unsigned ck = __hip_atomic_load(ckw, __ATOMIC_RELAXED, __HIP_MEMORY_SCOPE_AGENT);
        for (size_t i = (size_t)bid * 512 + threadIdx.x; i < (size_t)T * D; i += (size_t)nb * 512) { unsigned h = (ck ^ (unsigned)i) * 2654435761u; h ^= h >> 15; h *= 2246822519u; h ^= h >> 13; p.out[i] = (float)(h & 0xffffu) * (1.0f / 65536.0f); }
    }
#endif
}

extern "C" void kernel_launch(void* const* d_in, const int* in_sizes, int n_in, void* d_out, int out_size, void* d_ws, size_t ws_size, hipStream_t stream) {
    static int grid_blocks = 0;
    if (!grid_blocks) {
        if (n_in != 26 || out_size != T * D || ws_size < WS_NEED) { fprintf(stderr, "kernel_launch: unexpected shapes (n_in %d out %d ws %zu)\n", n_in, out_size, ws_size); grid_blocks = -1; return; }
        int dev = 0, cus = 0, per_cu = 0;
        hipGetDevice(&dev);
        hipDeviceGetAttribute(&cus, hipDeviceAttributeMultiprocessorCount, dev);
        hipFuncSetAttribute((const void*)mega, hipFuncAttributeMaxDynamicSharedMemorySize, LDS_BYTES);
        hipOccupancyMaxActiveBlocksPerMultiprocessor(&per_cu, (const void*)mega, 512, LDS_BYTES);
        if (per_cu < 1) per_cu = 1;
        grid_blocks = cus * 1;
        (void)hipGetLastError();
    }
    if (grid_blocks < 0) return;
    Params p{};
    for (int i = 0; i < 26; ++i) p.in[i] = (const float*)d_in[i];
    p.out = (float*)d_out; p.ws = (unsigned char*)d_ws;
#if ONE_LAUNCH
    p.st_lo = 0; p.st_hi = ST_COUNT;
    if (hipMemsetAsync((unsigned char*)d_ws + OFF_BAR, 0, XCD_BAR_WORDS * 4, stream) != hipSuccess) { fprintf(stderr, "kernel_launch: memset of the barrier words failed\n"); return; }
    void* args[] = {&p};
    hipError_t e = hipLaunchCooperativeKernel((const void*)mega, dim3(grid_blocks), dim3(512), args, LDS_BYTES, stream);
    if (e != hipSuccess) fprintf(stderr, "cooperative launch failed: %s (grid %d)\n", hipGetErrorString(e), grid_blocks);
#else
    int lo = 0;
    for (int st = 0; st < ST_COUNT; ++st) {
        if (sync_after(st) || st == ST_COUNT - 1) {
            p.st_lo = lo; p.st_hi = st + 1;
            hipLaunchKernelGGL(mega, dim3(grid_blocks), dim3(512), LDS_BYTES, stream, p);
            lo = st + 1;
        }
    }
#endif
}
```

```cpp
#include <hip/hip_runtime.h>
#include <hip/hip_cooperative_groups.h>
#include <cstdio>
#include <cstdint>
namespace cg = cooperative_groups;

#ifndef ONE_LAUNCH
#define ONE_LAUNCH 1
#endif

#define LAS __attribute__((address_space(3)))
typedef unsigned short bf16_t;
typedef short bf16x8 __attribute__((ext_vector_type(8)));
typedef float f32x4 __attribute__((ext_vector_type(4)));
typedef float f32x2 __attribute__((ext_vector_type(2)));
typedef unsigned u32x4 __attribute__((ext_vector_type(4)));
typedef unsigned u32x2 __attribute__((ext_vector_type(2)));

constexpr int T = 16384, D = 2048, SEQ = 8192, DFF = 5504;
constexpr int SLOT = 36864;
constexpr int RAWT = 67 * 128;
constexpr float EPS = 1e-6f;
constexpr int LDS_BYTES = 155648;
constexpr size_t MiB = 1ull << 20;
constexpr size_t OFF_PREP = 0, OFF_W0 = 288 * MiB, OFF_W1 = 313 * MiB, OFF_WZ = 317 * MiB, OFF_WGB = 325 * MiB, OFF_WGA = 333 * MiB,
    OFF_WPOOL = 341 * MiB, OFF_WA = 342 * MiB, OFF_WB = 350 * MiB, OFF_WMIX = 354 * MiB, OFF_WXQ = 362 * MiB, OFF_WXKV = 370 * MiB,
    OFF_WXO = 386 * MiB, OFF_AB = 394 * MiB, OFF_M = 396 * MiB, OFF_KM = 398 * MiB, OFF_VT = 400 * MiB, OFF_CD = 402 * MiB,
    OFF_POOLA = 403 * MiB, OFF_POOLB = 435 * MiB, OFF_WUP = 317 * MiB, OFF_WDOWN = 403 * MiB, OFF_H3 = 435 * MiB,
    OFF_YB = 435 * MiB, OFF_YA = 64 * MiB, OFF_Y = 160 * MiB, OFF_H2 = 0, OFF_Q = 64 * MiB, OFF_P = 128 * MiB, OFF_O = 0,
    OFF_ACT = 0, OFF_YDOWN = 172 * MiB, OFF_SSQ = 500 * MiB, OFF_XB = 236 * MiB, OFF_BAR = 509 * MiB, WS_NEED = 510 * MiB;

struct Params { const float* in[26]; float* out; unsigned char* ws; int st_lo, st_hi; };

typedef __bf16 bf16x2_t __attribute__((ext_vector_type(2)));
__device__ __forceinline__ unsigned cvt_pk_bf16(float lo, float hi) { f32x2 v = {lo, hi}; bf16x2_t b = __builtin_convertvector(v, bf16x2_t); return __builtin_bit_cast(unsigned, b); }
__device__ __forceinline__ float lo_bf(unsigned w) { return __uint_as_float(w << 16); }
__device__ __forceinline__ float hi_bf(unsigned w) { return __uint_as_float(w & 0xffff0000u); }
__device__ __forceinline__ float bf2f(bf16_t b) { return __uint_as_float(((unsigned)b) << 16); }
__device__ __forceinline__ float sigmoid_f(float x) { return __builtin_amdgcn_rcpf(1.0f + __expf(-x)); }
__device__ __forceinline__ float silu_f(float x) { return x * __builtin_amdgcn_rcpf(1.0f + __expf(-x)); }
#define LDS_WAIT() asm volatile("s_waitcnt lgkmcnt(0)" ::: "memory")
#define LDS_BARRIER() do { asm volatile("s_waitcnt lgkmcnt(0)" ::: "memory"); __builtin_amdgcn_s_barrier(); asm volatile("" ::: "memory"); } while (0)
__device__ __forceinline__ float dpp_add(float x, const int ctrl_sel) {
    int y;
    if (ctrl_sel == 0) y = __builtin_amdgcn_update_dpp(0, __float_as_int(x), 0xB1, 0xf, 0xf, true);
    else if (ctrl_sel == 1) y = __builtin_amdgcn_update_dpp(0, __float_as_int(x), 0x4E, 0xf, 0xf, true);
    else if (ctrl_sel == 2) y = __builtin_amdgcn_update_dpp(0, __float_as_int(x), 0x141, 0xf, 0xf, true);
    else y = __builtin_amdgcn_update_dpp(0, __float_as_int(x), 0x140, 0xf, 0xf, true);
    return x + __int_as_float(y);
}
__device__ __forceinline__ float dpp_red16(float x) { x = dpp_add(x, 0); x = dpp_add(x, 1); x = dpp_add(x, 2); x = dpp_add(x, 3); return x; }
__device__ __forceinline__ float wave_sum(float v) { v = dpp_red16(v); v += __shfl_xor(v, 16); v += __shfl_xor(v, 32); return v; }

namespace pg8 {
constexpr int BM = 256, BK = 64, HALF = 128, HTB = HALF * BK * 2, STAGE_BYTES = 8 * HTB, NXCD = 8, WGM = 4;
__host__ __device__ __forceinline__ int lds_byte(int r, int c) { const int st = (r >> 4) * 2 + (c >> 5), rr = r & 15, cc = c & 31, ob = rr * 64 + cc * 2; return st * 1024 + (ob ^ (((ob >> 9) & 1) << 5)); }
__host__ __device__ __forceinline__ void stage_rc(int b, int& R, int& C) { const int st = b / 1024, sb = b % 1024, swz = sb ^ (((sb >> 9) & 1) << 5); R = (st >> 1) * 16 + swz / 64; C = (st & 1) * 32 + (swz % 64) / 2; }
__host__ __device__ __forceinline__ int perm32(int rho) { const int n = rho >> 4, i = rho & 15; return 8 * (i >> 2) + 4 * n + (i & 3); }

struct Unit { const char* a; const char* b; int orow, ocol, pm, pn; };
struct GJob {
    const char* A; const char* B;
    long sA1, sA2, sB1, sB2;
    int lda, ldb;
    int K, nM, nN, G1, G2;
    int rstride;
    int orow0, oR1, oR2, oC1, oC2;
    int G, c;
    int direct;
    __device__ __forceinline__ bool next(int i, Unit& u) const {
        if (direct > 0) {
            if (i >= direct || c >= nM * G1 * G2) return false;
            const int g = c / nM, pm = c % nM, pn = i, g1 = g / G2, g2 = g % G2;
            u.pm = pm; u.pn = pn;
            u.a = A + g1 * sA1 + g2 * sA2 + (long)pm * rstride * lda;
            u.b = B + g1 * sB1 + g2 * sB2 + (long)pn * BM * ldb;
            u.orow = orow0 + g1 * oR1 + g2 * oR2 + pm * rstride;
            u.ocol = g1 * oC1 + g2 * oC2 + pn * BM;
            return true;
        }
        const long L = (long)i * G + c; const int nwg = nM * nN;
        if (L >= (long)nwg * G1 * G2) return false;
        const int g = (int)(L / nwg); int wgid = (int)(L % nwg);
        { const int q = nwg / NXCD, r = nwg % NXCD, xcd = wgid % NXCD, off = wgid / NXCD; wgid = (xcd < r ? xcd * (q + 1) : r * (q + 1) + (xcd - r) * q) + off; }
        const int nig = WGM * nN, gid = wgid / nig, fm = gid * WGM, gsz = (nM - fm) < WGM ? (nM - fm) : WGM;
        const int pm = fm + ((wgid % nig) % gsz), pn = (wgid % nig) / gsz;
        const int g1 = g / G2, g2 = g % G2;
        u.pm = pm; u.pn = pn;
        u.a = A + g1 * sA1 + g2 * sA2 + (long)pm * rstride * lda;
        u.b = B + g1 * sB1 + g2 * sB2 + (long)pn * BM * ldb;
        u.orow = orow0 + g1 * oR1 + g2 * oR2 + pm * rstride;
        u.ocol = g1 * oC1 + g2 * oC2 + pn * BM;
        return true;
    }
};

template <class Epi>
__device__ __forceinline__ void gemm_phase(LAS unsigned char* lds, const GJob& S, const Epi& E) {
    const int tid = threadIdx.x, wid = __builtin_amdgcn_readfirstlane(tid >> 6), lane = tid & 63, wr = wid >> 2, wc = wid & 3, fr = lane & 15, fq = lane >> 4;
    const int nt = S.K / BK;
    unsigned voffA[2], voffB[2];
#pragma unroll
    for (int i = 0; i < 2; ++i) { int R, C; stage_rc(tid * 16 + i * 8192, R, C); const int Rb = Epi::PERM ? ((R & ~31) + perm32(R & 31)) : R;
        voffA[i] = (unsigned)(R * S.lda + C * 2); voffB[i] = (unsigned)(Rb * S.ldb + C * 2); }
    const size_t kstep = (size_t)(BK * 2);
    const size_t hstepA = (size_t)HALF * S.lda, hstepB = (size_t)HALF * S.ldb;
    const unsigned ldsw = (unsigned)wid * 1024u;
    const int aoff = lds_byte(wr * 64 + fr, fq * 8), boff = lds_byte(wc * 32 + fr, fq * 8);
#define PG8_SA(b, h) (((b) * 2 + (h)) * HTB)
#define PG8_SB(b, h) ((4 + (b) * 2 + (h)) * HTB)
#define PG8_STAGE(bufoff, gbase, voff) do { _Pragma("unroll") for (int _i = 0; _i < 2; ++_i) \
        __builtin_amdgcn_global_load_lds((const unsigned*)((const char*)(gbase) + (voff)[_i]), (LAS unsigned*)(lds + (bufoff) + ldsw + _i * 8192), 16, 0, 0); } while (0)
#define PG8_LDA(dst, b, h) do { _Pragma("unroll") for (int m = 0; m < 4; ++m) _Pragma("unroll") for (int k = 0; k < 2; ++k) dst[m][k] = *(const LAS bf16x8*)(lds + PG8_SA(b, h) + aoff + m * 2048 + k * 1024); } while (0)
#define PG8_LDB(dst, b, h) do { _Pragma("unroll") for (int n = 0; n < 2; ++n) _Pragma("unroll") for (int k = 0; k < 2; ++k) dst[n][k] = *(const LAS bf16x8*)(lds + PG8_SB(b, h) + boff + n * 2048 + k * 1024); } while (0)
#define PG8_MMA(ai, bj, At, Bt) do { __builtin_amdgcn_s_setprio(1); _Pragma("unroll") for (int m = 0; m < 4; ++m) _Pragma("unroll") for (int n = 0; n < 2; ++n) _Pragma("unroll") for (int k = 0; k < 2; ++k) \
        acc[ai][bj][m][n] = __builtin_amdgcn_mfma_f32_16x16x32_bf16(Bt[n][k], At[m][k], acc[ai][bj][m][n], 0, 0, 0); __builtin_amdgcn_s_setprio(0); } while (0)
#define PG8_WAIT_V(n) asm volatile("s_waitcnt vmcnt(" #n ")" ::: "memory")
#define PG8_WAIT_L(n) asm volatile("s_waitcnt lgkmcnt(" #n ")" ::: "memory")
#define PG8_BAR __builtin_amdgcn_s_barrier()
#define PG8_SCHED __builtin_amdgcn_sched_barrier(0)
    Unit cur, nxt; int ui = 0;
    if (!S.next(0, cur)) return;
    f32x4 acc[2][2][4][2];
#pragma unroll
    for (int a = 0; a < 2; ++a)
#pragma unroll
        for (int b = 0; b < 2; ++b)
#pragma unroll
            for (int m = 0; m < 4; ++m)
#pragma unroll
                for (int n = 0; n < 2; ++n) acc[a][b][m][n] = (f32x4){0.f, 0.f, 0.f, 0.f};
    bf16x8 At[4][2], B0[2][2], B1[2][2];
    const char* cA = cur.a; const char* cB = cur.b;
    PG8_STAGE(PG8_SB(0, 0), cB, voffB); PG8_STAGE(PG8_SB(0, 1), cB + hstepB, voffB); PG8_STAGE(PG8_SA(0, 0), cA, voffA); PG8_STAGE(PG8_SA(0, 1), cA + hstepA, voffA);
    if (wr == 1) PG8_BAR;
    PG8_WAIT_V(2); PG8_BAR;
    PG8_STAGE(PG8_SB(1, 0), cB + kstep, voffB); PG8_STAGE(PG8_SA(1, 0), cA + kstep, voffA); PG8_STAGE(PG8_SB(1, 1), cB + hstepB + kstep, voffB);
    PG8_WAIT_V(6); PG8_BAR;
    for (;;) {
        const bool has_next = S.next(ui + 1, nxt);
        const char* nA = has_next ? nxt.a : cA; const char* nB = has_next ? nxt.b : cB;
        for (int t = 0; t < nt; t += 2) {
            const bool last = (t == nt - 2);
            const char* a1 = cA + (size_t)(t + 1) * kstep;
            const char* a2 = last ? nA : cA + (size_t)(t + 2) * kstep; const char* b2 = last ? nB : cB + (size_t)(t + 2) * kstep;
            const char* a3 = a2 + kstep; const char* b3 = b2 + kstep;
            PG8_LDB(B0, 0, 0); PG8_LDB(B1, 0, 1); PG8_SCHED; PG8_LDA(At, 0, 0); PG8_STAGE(PG8_SA(1, 1), a1 + hstepA, voffA);
            PG8_WAIT_V(8); PG8_WAIT_L(0); PG8_BAR; PG8_MMA(0, 0, At, B0); PG8_MMA(0, 1, At, B1); PG8_BAR; PG8_SCHED;
            PG8_LDA(At, 0, 1); PG8_STAGE(PG8_SB(0, 0), b2, voffB); PG8_STAGE(PG8_SB(0, 1), b2 + hstepB, voffB); PG8_STAGE(PG8_SA(0, 0), a2, voffA);
            PG8_WAIT_V(8); PG8_WAIT_L(0); PG8_BAR; PG8_MMA(1, 0, At, B0); PG8_MMA(1, 1, At, B1); PG8_BAR; PG8_SCHED;
            PG8_LDB(B0, 1, 0); PG8_LDB(B1, 1, 1); PG8_SCHED; PG8_LDA(At, 1, 0); PG8_STAGE(PG8_SA(0, 1), a2 + hstepA, voffA);
            PG8_WAIT_V(8); PG8_WAIT_L(0); PG8_BAR; PG8_MMA(0, 0, At, B0); PG8_MMA(0, 1, At, B1); PG8_BAR; PG8_SCHED;
            PG8_LDA(At, 1, 1); PG8_STAGE(PG8_SB(1, 0), b3, voffB); PG8_STAGE(PG8_SB(1, 1), b3 + hstepB, voffB); PG8_STAGE(PG8_SA(1, 0), a3, voffA);
            PG8_WAIT_V(8); PG8_WAIT_L(0); PG8_BAR; PG8_MMA(1, 0, At, B0); PG8_MMA(1, 1, At, B1); PG8_BAR; PG8_SCHED;
        }
        if (wr == 0) PG8_BAR;
        E(acc, cur, wr, wc, fr, fq, lds + STAGE_BYTES);
        if (!has_next) break;
#pragma unroll
        for (int a = 0; a < 2; ++a)
#pragma unroll
            for (int b = 0; b < 2; ++b)
#pragma unroll
                for (int m = 0; m < 4; ++m)
#pragma unroll
                    for (int n = 0; n < 2; ++n) acc[a][b][m][n] = (f32x4){0.f, 0.f, 0.f, 0.f};
        cur = nxt; cA = nA; cB = nB; ++ui;
        if (wr == 1) PG8_BAR;
    }
    PG8_WAIT_V(0);
    PG8_BAR;
#undef PG8_SA
#undef PG8_SB
#undef PG8_STAGE
#undef PG8_LDA
#undef PG8_LDB
#undef PG8_MMA
#undef PG8_WAIT_V
#undef PG8_WAIT_L
#undef PG8_SCHED
}
}
using pg8::GJob; using pg8::Unit;
typedef f32x4 AccT[2][2][4][2];

struct EpiB {
    static constexpr bool PERM = true;
    bf16_t* O; int ldc; int mode; const bf16_t* aux1; const bf16_t* aux2; const float* cscale; const float* ssq; const float* gn;
    __device__ __forceinline__ void operator()(AccT& acc, const Unit& u, int wr, int wc, int fr, int fq, LAS unsigned char*) const {
        const int row0 = u.orow + wr * 64 + fr, col0 = u.ocol + wc * 32 + 8 * fq;
#pragma unroll
        for (int ai = 0; ai < 2; ++ai)
#pragma unroll
            for (int m = 0; m < 4; ++m) {
                const size_t off = (size_t)(row0 + ai * 128 + m * 16) * ldc + col0;
#pragma unroll
                for (int bj = 0; bj < 2; ++bj) {
                    f32x4 v0 = acc[ai][bj][m][0], v1 = acc[ai][bj][m][1];
                    if (mode == 5) {
                        v0 = (f32x4){sigmoid_f(v0[0]), sigmoid_f(v0[1]), sigmoid_f(v0[2]), sigmoid_f(v0[3])}; v1 = (f32x4){sigmoid_f(v1[0]), sigmoid_f(v1[1]), sigmoid_f(v1[2]), sigmoid_f(v1[3])};
                    } else if (mode == 6 || mode == 7) {
                        const u32x4 a = *(const u32x4*)(aux1 + off + bj * 128);
                        v0 *= (f32x4){lo_bf(a.x), hi_bf(a.x), lo_bf(a.y), hi_bf(a.y)}; v1 *= (f32x4){lo_bf(a.z), hi_bf(a.z), lo_bf(a.w), hi_bf(a.w)};
                        if (mode == 7) { const u32x4 c = *(const u32x4*)(aux2 + off + bj * 128);
                            v0 += (f32x4){lo_bf(c.x), hi_bf(c.x), lo_bf(c.y), hi_bf(c.y)}; v1 += (f32x4){lo_bf(c.z), hi_bf(c.z), lo_bf(c.w), hi_bf(c.w)}; }
                    } else if (mode >= 1 && mode <= 3) {
                        const u32x4 a = *(const u32x4*)(aux1 + off + bj * 128);
                        const float a0 = lo_bf(a.x), a1 = hi_bf(a.x), a2 = lo_bf(a.y), a3 = hi_bf(a.y), a4 = lo_bf(a.z), a5 = hi_bf(a.z), a6 = lo_bf(a.w), a7 = hi_bf(a.w);
                        if (mode == 1) {
                            const int cg = col0 + bj * 128, hd = cg >> 7, cm = cg & 127;
                            const float* sp = ssq + (size_t)(row0 + ai * 128 + m * 16) * 128 + hd * 8;
                            const f32x4 s0 = *(const f32x4*)sp, s1 = *(const f32x4*)(sp + 4);
                            const float rs = rsqrtf(((s0[0] + s0[1]) + (s0[2] + s0[3]) + (s1[0] + s1[1]) + (s1[2] + s1[3])) * (1.0f / 128.0f) + EPS);
                            const f32x4 g0 = *(const f32x4*)(gn + cm) * rs, g1 = *(const f32x4*)(gn + cm + 4) * rs;
                            v0 = (f32x4){silu_f(v0[0]) * a0 * g0[0], silu_f(v0[1]) * a1 * g0[1], silu_f(v0[2]) * a2 * g0[2], silu_f(v0[3]) * a3 * g0[3]};
                            v1 = (f32x4){silu_f(v1[0]) * a4 * g1[0], silu_f(v1[1]) * a5 * g1[1], silu_f(v1[2]) * a6 * g1[2], silu_f(v1[3]) * a7 * g1[3]}; }
                        else { v0 = (f32x4){sigmoid_f(v0[0]) * a0, sigmoid_f(v0[1]) * a1, sigmoid_f(v0[2]) * a2, sigmoid_f(v0[3]) * a3};
                               v1 = (f32x4){sigmoid_f(v1[0]) * a4, sigmoid_f(v1[1]) * a5, sigmoid_f(v1[2]) * a6, sigmoid_f(v1[3]) * a7}; }
                        if (mode == 3) { const u32x4 c = *(const u32x4*)(aux2 + off + bj * 128);
                            v0 += (f32x4){lo_bf(c.x), hi_bf(c.x), lo_bf(c.y), hi_bf(c.y)}; v1 += (f32x4){lo_bf(c.z), hi_bf(c.z), lo_bf(c.w), hi_bf(c.w)}; }
                    } else if (mode == 4) {
                        v0 *= *(const f32x4*)(cscale + col0 + bj * 128); v1 *= *(const f32x4*)(cscale + col0 + bj * 128 + 4);
                    }
                    u32x4 w; w.x = cvt_pk_bf16(v0[0], v0[1]); w.y = cvt_pk_bf16(v0[2], v0[3]); w.z = cvt_pk_bf16(v1[0], v1[1]); w.w = cvt_pk_bf16(v1[2], v1[3]);
                    *(u32x4*)(O + off + bj * 128) = w;
                }
            }
    }
};
struct EpiF {
    static constexpr bool PERM = false;
    float* C; int ldc;
    __device__ __forceinline__ void operator()(AccT& acc, const Unit& u, int wr, int wc, int fr, int fq, LAS unsigned char*) const {
        const int row0 = u.orow + wr * 64 + fr, col0 = u.ocol + wc * 32 + 4 * fq;
#pragma unroll
        for (int ai = 0; ai < 2; ++ai)
#pragma unroll
            for (int m = 0; m < 4; ++m) { float* rowp = C + (size_t)(row0 + ai * 128 + m * 16) * ldc + col0;
#pragma unroll
                for (int bj = 0; bj < 2; ++bj)
#pragma unroll
                    for (int n = 0; n < 2; ++n) *(f32x4*)(rowp + bj * 128 + n * 16) = acc[ai][bj][m][n]; }
    }
};
struct EpiQKV {
    static constexpr bool PERM = true;
    bf16_t* prep; float* ab; bf16_t* poola;
    __device__ __forceinline__ void operator()(AccT& acc, const Unit& u, int wr, int wc, int fr, int fq, LAS unsigned char*) const {
        if (u.pn < 24) {
#pragma unroll
            for (int bj = 0; bj < 2; ++bj) {
                const int cb = 2 * u.pn + bj, ty = cb >> 4, hh = cb & 15, d = wc * 32 + 8 * fq;
#pragma unroll
                for (int ai = 0; ai < 2; ++ai)
#pragma unroll
                    for (int m = 0; m < 4; ++m) {
                        const int t = u.orow + ai * 128 + wr * 64 + m * 16 + fr, b = t >> 13, pos = t & 8191, n = pos >> 6, i = pos & 63;
                        const size_t idx = (size_t)((b * 16 + hh) * 128 + n);
                        const f32x4 v0 = acc[ai][bj][m][0], v1 = acc[ai][bj][m][1];
                        u32x4 w; w.x = cvt_pk_bf16(v0[0], v0[1]); w.y = cvt_pk_bf16(v0[2], v0[3]); w.z = cvt_pk_bf16(v1[0], v1[1]); w.w = cvt_pk_bf16(v1[2], v1[3]);
                        *(u32x4*)(prep + idx * SLOT + ty * RAWT + (3 + i) * 128 + d) = w;
                        if (i >= 61 && n < 127) *(u32x4*)(prep + (idx + 1) * SLOT + ty * RAWT + (i - 61) * 128 + d) = w;
                    }
            }
        } else if (u.pn == 24) {
            if (wc == 0) {
#pragma unroll
                for (int ai = 0; ai < 2; ++ai)
#pragma unroll
                    for (int m = 0; m < 4; ++m) { const int t = u.orow + ai * 128 + wr * 64 + m * 16 + fr;
#pragma unroll
                        for (int n = 0; n < 2; ++n) *(f32x4*)(ab + (size_t)t * 32 + 8 * fq + 4 * n) = acc[ai][0][m][n]; }
            }
        } else {
            const int col0 = (u.pn - 25) * 256 + wc * 32 + 8 * fq;
#pragma unroll
            for (int ai = 0; ai < 2; ++ai)
#pragma unroll
                for (int m = 0; m < 4; ++m) { const int t = u.orow + ai * 128 + wr * 64 + m * 16 + fr;
#pragma unroll
                    for (int bj = 0; bj < 2; ++bj) { const f32x4 v0 = acc[ai][bj][m][0], v1 = acc[ai][bj][m][1];
                        u32x4 w; w.x = cvt_pk_bf16(v0[0], v0[1]); w.y = cvt_pk_bf16(v0[2], v0[3]); w.z = cvt_pk_bf16(v1[0], v1[1]); w.w = cvt_pk_bf16(v1[2], v1[3]);
                        *(u32x4*)(poola + (size_t)t * 1024 + col0 + bj * 128) = w; } }
        }
    }
};
struct EpiSM {
    static constexpr bool PERM = true;
    bf16_t* P;
    __device__ __forceinline__ void operator()(AccT& acc, const Unit& u, int wr, int wc, int fr, int fq, LAS unsigned char* ldsx) const {
        const float sc = 0.04419417382415922f * 1.4426950408889634f;
        LAS f32x2* X = (LAS f32x2*)ldsx;
        float mw[2][4];
#pragma unroll
        for (int ai = 0; ai < 2; ++ai)
#pragma unroll
            for (int m = 0; m < 4; ++m) {
                float mx = -3.0e38f;
#pragma unroll
                for (int bj = 0; bj < 2; ++bj)
#pragma unroll
                    for (int n = 0; n < 2; ++n) { const f32x4 v = acc[ai][bj][m][n]; mx = fmaxf(mx, fmaxf(fmaxf(v[0], v[1]), fmaxf(v[2], v[3]))); }
                mx = fmaxf(mx, __shfl_xor(mx, 16)); mx = fmaxf(mx, __shfl_xor(mx, 32));
                float s = 0.f;
#pragma unroll
                for (int bj = 0; bj < 2; ++bj)
#pragma unroll
                    for (int n = 0; n < 2; ++n) { f32x4 v = acc[ai][bj][m][n];
#pragma unroll
                        for (int j = 0; j < 4; ++j) { v[j] = __builtin_amdgcn_exp2f((v[j] - mx) * sc); s += v[j]; }
                        acc[ai][bj][m][n] = v; }
                s += __shfl_xor(s, 16); s += __shfl_xor(s, 32);
                if (fq == 0) X[(ai * 128 + wr * 64 + m * 16 + fr) * 4 + wc] = (f32x2){mx, s};
                mw[ai][m] = mx;
            }
        LDS_WAIT(); __builtin_amdgcn_s_barrier(); asm volatile("" ::: "memory");
#pragma unroll
        for (int ai = 0; ai < 2; ++ai)
#pragma unroll
            for (int m = 0; m < 4; ++m) {
                const int r = ai * 128 + wr * 64 + m * 16 + fr;
                const f32x2 p0 = X[r * 4 + 0], p1 = X[r * 4 + 1], p2 = X[r * 4 + 2], p3 = X[r * 4 + 3];
                const float M = fmaxf(fmaxf(p0.x, p1.x), fmaxf(p2.x, p3.x));
                const float L = p0.y * __builtin_amdgcn_exp2f((p0.x - M) * sc) + p1.y * __builtin_amdgcn_exp2f((p1.x - M) * sc) + p2.y * __builtin_amdgcn_exp2f((p2.x - M) * sc) + p3.y * __builtin_amdgcn_exp2f((p3.x - M) * sc);
                const float f = __builtin_amdgcn_exp2f((mw[ai][m] - M) * sc) / L;
                bf16_t* rowp = P + (size_t)(u.orow + r) * 256 + wc * 32 + 8 * fq;
#pragma unroll
                for (int bj = 0; bj < 2; ++bj) { const f32x4 v0 = acc[ai][bj][m][0] * f, v1 = acc[ai][bj][m][1] * f;
                    u32x4 w; w.x = cvt_pk_bf16(v0[0], v0[1]); w.y = cvt_pk_bf16(v0[2], v0[3]); w.z = cvt_pk_bf16(v1[0], v1[1]); w.w = cvt_pk_bf16(v1[2], v1[3]);
                    *(u32x4*)(rowp + bj * 128) = w; }
            }
    }
};
template <int N> __device__ __forceinline__ f32x4 ror4(f32x4 v) {
    f32x4 r;
#pragma unroll
    for (int j = 0; j < 4; ++j) r[j] = __int_as_float(__builtin_amdgcn_update_dpp(0, __float_as_int(v[j]), 0x120 + N, 0xf, 0xf, true));
    return r;
}
struct EpiCG {
    static constexpr bool PERM = true;
    bf16_t* act; const float* cw; const float* cb;
    __device__ __forceinline__ void operator()(AccT& acc, const Unit& u, int wr, int wc, int fr, int fq, LAS unsigned char* ldsx) const {
        LAS float* X = (LAS float*)ldsx;
        const int lane = fq * 16 + fr;
        if (fr >= 14) {
#pragma unroll
            for (int ai = 0; ai < 2; ++ai)
#pragma unroll
                for (int bj = 0; bj < 2; ++bj)
#pragma unroll
                    for (int n = 0; n < 2; ++n) *(LAS f32x4*)(X + ((2 * ai + wr) * 2 + (fr - 14)) * 256 + bj * 128 + wc * 32 + 8 * fq + 4 * n) = acc[ai][bj][3][n];
        }
        LDS_WAIT(); __builtin_amdgcn_s_barrier(); asm volatile("" ::: "memory");
#pragma unroll
        for (int n = 0; n < 2; ++n) {
            const int ch = u.pn * 128 + wc * 32 + 8 * fq + 4 * n;
            f32x4 w0[2], w1[2], w2[2], bs[2];
#pragma unroll
            for (int bj = 0; bj < 2; ++bj) { const int c = ch + bj * DFF; w0[bj] = *(const f32x4*)(cw + c); w1[bj] = *(const f32x4*)(cw + 2 * DFF + c); w2[bj] = *(const f32x4*)(cw + 4 * DFF + c); bs[bj] = *(const f32x4*)(cb + c); }
#pragma unroll
            for (int ai = 0; ai < 2; ++ai) {
                int blkp = 2 * ai + wr - 1; if (blkp < 0) blkp = 0;
                f32x4 h62[2], h63[2], p1p[2], p2p[2];
#pragma unroll
                for (int bj = 0; bj < 2; ++bj) { h62[bj] = *(const LAS f32x4*)(X + (blkp * 2 + 0) * 256 + bj * 128 + wc * 32 + 8 * fq + 4 * n); h63[bj] = *(const LAS f32x4*)(X + (blkp * 2 + 1) * 256 + bj * 128 + wc * 32 + 8 * fq + 4 * n); p1p[bj] = h63[bj]; p2p[bj] = (fr == 0) ? h62[bj] : h63[bj]; }
#pragma unroll
                for (int m = 0; m < 4; ++m) {
                    const int rt = ai * 128 + wr * 64 + m * 16 + fr, t = u.orow + rt, pos = t & 8191;
                    f32x4 uu[2];
#pragma unroll
                    for (int bj = 0; bj < 2; ++bj) {
                        const f32x4 cur = acc[ai][bj][m][n];
                        const f32x4 p1 = ror4<1>(cur), p2 = ror4<2>(cur);
                        f32x4 prev1 = (fr >= 1) ? p1 : p1p[bj];
                        f32x4 prev2 = (fr >= 2) ? p2 : p2p[bj];
                        p1p[bj] = p1; p2p[bj] = p2;
                        if (pos == 0) prev1 = (f32x4){0.f, 0.f, 0.f, 0.f};
                        if (pos <= 1) prev2 = (f32x4){0.f, 0.f, 0.f, 0.f};
                        uu[bj] = w2[bj] * cur + w1[bj] * prev1 + w0[bj] * prev2 + bs[bj];
                    }
                    u32x2 w; w.x = cvt_pk_bf16(silu_f(uu[0][0]) * uu[1][0], silu_f(uu[0][1]) * uu[1][1]); w.y = cvt_pk_bf16(silu_f(uu[0][2]) * uu[1][2], silu_f(uu[0][3]) * uu[1][3]);
                    if (rt >= 2 && t < T) *(u32x2*)(act + (size_t)t * DFF + ch) = w;
                }
            }
        }
    }
};

struct TDesc { const float* src; bf16_t* dst; int ldw; int K; };
__device__ __forceinline__ void t_load(const TDesc& d, f32x4 (&t)[8], int lane) {
#pragma unroll
    for (int i = 0; i < 8; ++i) t[i] = *(const f32x4*)(d.src + (size_t)(8 * i + (lane >> 3)) * d.ldw + (lane & 7) * 4);
}
__device__ __forceinline__ void t_finish(const TDesc& d, const f32x4 (&t)[8], LAS float* scr, int lane) {
#pragma unroll
    for (int i = 0; i < 8; ++i) { LAS float* sp = scr + (8 * i + (lane >> 3)) * 33 + (lane & 7) * 4; sp[0] = t[i][0]; sp[1] = t[i][1]; sp[2] = t[i][2]; sp[3] = t[i][3]; }
    LDS_WAIT();
    const int c = lane & 7;
#pragma unroll
    for (int j = 0; j < 4; ++j) { const int n = (lane >> 3) + 8 * j; const LAS float* s = scr + (8 * c) * 33 + n;
        u32x4 o; o.x = cvt_pk_bf16(s[0 * 33], s[1 * 33]); o.y = cvt_pk_bf16(s[2 * 33], s[3 * 33]); o.z = cvt_pk_bf16(s[4 * 33], s[5 * 33]); o.w = cvt_pk_bf16(s[6 * 33], s[7 * 33]);
        *(u32x4*)(d.dst + (size_t)n * d.K + 8 * c) = o; }
    LDS_WAIT();
}
#define TJOB(src_, ldw_, Kdim, col0, ncols, dst_, drow0, kind) if (!found) { const int nbk = (ncols) / 32, items = ((Kdim) / 64) * nbk; \
    if (r < items) { const int kb = r / nbk, nb = r % nbk; int dr = (drow0) + nb * 32; \
        if (kind) { const int cc = nb * 32; dr = cc < DFF ? (cc / 128) * 256 + (cc % 128) : ((cc - DFF) / 128) * 256 + 128 + ((cc - DFF) % 128); } \
        d.src = (src_) + (size_t)(kb * 64) * (ldw_) + (col0) + nb * 32; d.dst = (dst_) + (size_t)dr * (Kdim) + kb * 64; d.ldw = (ldw_); d.K = (Kdim); found = true; } else r -= items; }
struct Lookup0 {
    const Params* p;
    __device__ __forceinline__ bool operator()(int it, TDesc& d) const {
        constexpr int DIN = 13344;
        constexpr int NIT = 32 * (192 + 1 + 32 + 64) + 32 * 128;
        if (it >= NIT) return false;
        unsigned char* ws = p->ws; const float* w_in = p->in[3]; int r = it; bool found = false;
        TJOB(w_in, DIN, 2048, 0, 6144, (bf16_t*)(ws + OFF_W0), 0, 0)
        TJOB(w_in, DIN, 2048, 8192, 32, (bf16_t*)(ws + OFF_W0), 6144, 0)
        TJOB(w_in, DIN, 2048, 8224, 1024, (bf16_t*)(ws + OFF_W1), 0, 0)
        TJOB(w_in, DIN, 2048, 11296, 2048, (bf16_t*)(ws + OFF_WGB), 0, 0)
        TJOB(p->in[17], 4096, 2048, 0, 4096, (bf16_t*)(ws + OFF_WXKV), 0, 0)
        return found;
    }
};
struct LookupDeferred {
    const Params* p;
    __device__ __forceinline__ bool operator()(int it, TDesc& d) const {
        constexpr int DIN = 13344;
        constexpr int NIT = 32 * (64 + 64) + 4 * 4 * 8 + 32 * 64 + 16 * 64 + 32 * 64 * 3;
        if (it >= NIT) return false;
        unsigned char* ws = p->ws; const float* w_in = p->in[3]; int r = it; bool found = false;
        TJOB(w_in, DIN, 2048, 6144, 2048, (bf16_t*)(ws + OFF_WZ), 0, 0)
        TJOB(w_in, DIN, 2048, 9248, 2048, (bf16_t*)(ws + OFF_WGA), 0, 0)
        TJOB(p->in[8], 256, 256, 0, 256, (bf16_t*)(ws + OFF_WPOOL), 0, 0)
        TJOB(p->in[8] + 65536, 256, 256, 0, 256, (bf16_t*)(ws + OFF_WPOOL), 256, 0)
        TJOB(p->in[8] + 2 * 65536, 256, 256, 0, 256, (bf16_t*)(ws + OFF_WPOOL), 512, 0)
        TJOB(p->in[8] + 3 * 65536, 256, 256, 0, 256, (bf16_t*)(ws + OFF_WPOOL), 768, 0)
        TJOB(p->in[10], 2048, 2048, 0, 2048, (bf16_t*)(ws + OFF_WA), 0, 0)
        TJOB(p->in[11], 2048, 1024, 0, 2048, (bf16_t*)(ws + OFF_WB), 0, 0)
        TJOB(p->in[12], 2048, 2048, 0, 2048, (bf16_t*)(ws + OFF_WMIX), 0, 0)
        TJOB(p->in[16], 2048, 2048, 0, 2048, (bf16_t*)(ws + OFF_WXQ), 0, 0)
        TJOB(p->in[18], 2048, 2048, 0, 2048, (bf16_t*)(ws + OFF_WXO), 0, 0)
        return found;
    }
};
struct LookupLate {
    const Params* p;
    __device__ __forceinline__ bool operator()(int it, TDesc& d) const {
        if (it >= 86 * 64 + 32 * 344) return false;
        unsigned char* ws = p->ws; int r = it; bool found = false;
        TJOB(p->in[24], 2048, 5504, 0, 2048, (bf16_t*)(ws + OFF_WDOWN), 0, 0)
        TJOB(p->in[21], 11008, 2048, 0, 11008, (bf16_t*)(ws + OFF_WUP), 0, 1)
        return found;
    }
};
template <class LK>
__device__ __forceinline__ void transpose_stream(const LK& lk, int first, int stride, LAS float* scr, int lane) {
    TDesc cur, nxt; f32x4 tc[8], tn[8];
    int it = first;
    bool hc = lk(it, cur);
    if (hc) t_load(cur, tc, lane);
    while (hc) {
        const bool hn = lk(it + stride, nxt);
        if (hn) t_load(nxt, tn, lane);
        t_finish(cur, tc, scr, lane);
        cur = nxt; hc = hn; it += stride;
#pragma unroll
        for (int i = 0; i < 8; ++i) tc[i] = tn[i];
    }
}

__device__ __forceinline__ void rms_row_to_bf16(const float* xrow, const float* w, bf16_t* orow, int lane) {
    f32x4 v[8]; float ss = 0.f;
#pragma unroll
    for (int j = 0; j < 8; ++j) { v[j] = *(const f32x4*)(xrow + 4 * lane + 256 * j); ss += (v[j][0] * v[j][0] + v[j][1] * v[j][1]) + (v[j][2] * v[j][2] + v[j][3] * v[j][3]); }
    const float r = rsqrtf(wave_sum(ss) * (1.0f / D) + EPS);
#pragma unroll
    for (int j = 0; j < 8; ++j) { const f32x4 g = *(const f32x4*)(w + 4 * lane + 256 * j); const f32x4 y = v[j] * r * g;
        u32x2 o; o.x = cvt_pk_bf16(y[0], y[1]); o.y = cvt_pk_bf16(y[2], y[3]); *(u32x2*)(orow + 4 * lane + 256 * j) = o; }
}

__device__ __forceinline__ void phase_convert0(const Params& p, LAS unsigned char* lds, int bid, int nb) {
    const int tid = threadIdx.x, lane = tid & 63, wid = tid >> 6;
    LAS float* scr = (LAS float*)(lds + wid * 8448);
    const int gw = bid * 8 + wid, ngw = nb * 8;
    unsigned char* ws = p.ws;
    { Lookup0 lk; lk.p = &p; transpose_stream(lk, gw, ngw, scr, lane); }
    { u32x4* z = (u32x4*)(ws + OFF_W0 + (size_t)6176 * 4096); const int nz = 224 * 4096 / 16;
      for (int i = bid * 512 + tid; i < nz; i += nb * 512) z[i] = (u32x4){0u, 0u, 0u, 0u}; }
    {
        f32x4 vc[8], vn[8];
        int row = gw;
#define RMS_SRC(r_) ((r_) < T ? p.in[0] + (size_t)(r_) * D : p.in[1] + (size_t)((r_) - T) * D)
        if (row < T + 512) {
#pragma unroll
            for (int j = 0; j < 8; ++j) vc[j] = *(const f32x4*)(RMS_SRC(row) + 4 * lane + 256 * j);
        }
        for (; row < T + 512; row += ngw) {
            const int nrow = row + ngw;
            if (nrow < T + 512) {
#pragma unroll
                for (int j = 0; j < 8; ++j) vn[j] = *(const f32x4*)(RMS_SRC(nrow) + 4 * lane + 256 * j);
            }
            const float* wv = row < T ? p.in[2] : p.in[15];
            bf16_t* orow = row < T ? (bf16_t*)p.out + (size_t)row * D : (bf16_t*)(ws + OFF_M) + (size_t)(row - T) * D;
            float ss = 0.f;
#pragma unroll
            for (int j = 0; j < 8; ++j) ss += (vc[j][0] * vc[j][0] + vc[j][1] * vc[j][1]) + (vc[j][2] * vc[j][2] + vc[j][3] * vc[j][3]);
            const float r = rsqrtf(wave_sum(ss) * (1.0f / D) + EPS);
#pragma unroll
            for (int j = 0; j < 8; ++j) { const f32x4 g = *(const f32x4*)(wv + 4 * lane + 256 * j); const f32x4 yv = vc[j] * r * g;
                u32x2 o; o.x = cvt_pk_bf16(yv[0], yv[1]); o.y = cvt_pk_bf16(yv[2], yv[3]); *(u32x2*)(orow + 4 * lane + 256 * j) = o; }
#pragma unroll
            for (int j = 0; j < 8; ++j) vc[j] = vn[j];
        }
#undef RMS_SRC
    }
}
__device__ __forceinline__ void phase_convert_late(const Params& p, LAS unsigned char* lds, int bid, int nb) {
    const int tid = threadIdx.x, lane = tid & 63, wid = tid >> 6;
    LAS float* scr = (LAS float*)(lds + wid * 8448);
    const int gw = bid * 8 + wid, ngw = nb * 8;
    { LookupLate lk; lk.p = &p; transpose_stream(lk, gw, ngw, scr, lane); }
}

__device__ __forceinline__ void phase_rows(const bf16_t* y, const float* xin32, const bf16_t* xin16, float* xout32, bf16_t* xout16, const float* wpost, const float* wpre, bf16_t* hout, int gw, int ngw, int lane) {
    u32x2 yc[8], yn[8]; f32x4 xc[8], xn[8];
    int row = gw;
#define ROWS_LOAD(yv, xv, r_) do { _Pragma("unroll") for (int j = 0; j < 8; ++j) { yv[j] = *(const u32x2*)(y + (size_t)(r_) * D + 4 * lane + 256 * j); \
        if (xin32) xv[j] = *(const f32x4*)(xin32 + (size_t)(r_) * D + 4 * lane + 256 * j); \
        else { const u32x2 xb = *(const u32x2*)(xin16 + (size_t)(r_) * D + 4 * lane + 256 * j); xv[j] = (f32x4){lo_bf(xb.x), hi_bf(xb.x), lo_bf(xb.y), hi_bf(xb.y)}; } } } while (0)
    if (row < T) ROWS_LOAD(yc, xc, row);
    for (; row < T; row += ngw) {
        const int nrow = row + ngw;
        if (nrow < T) ROWS_LOAD(yn, xn, nrow);
        f32x4 v[8]; float ss = 0.f;
#pragma unroll
        for (int j = 0; j < 8; ++j) { v[j] = (f32x4){lo_bf(yc[j].x), hi_bf(yc[j].x), lo_bf(yc[j].y), hi_bf(yc[j].y)}; ss += (v[j][0] * v[j][0] + v[j][1] * v[j][1]) + (v[j][2] * v[j][2] + v[j][3] * v[j][3]); }
        const float r = rsqrtf(wave_sum(ss) * (1.0f / D) + EPS);
        float s2 = 0.f;
#pragma unroll
        for (int j = 0; j < 8; ++j) { const f32x4 g = *(const f32x4*)(wpost + 4 * lane + 256 * j);
            v[j] = xc[j] + v[j] * r * g;
            if (xout32) *(f32x4*)(xout32 + (size_t)row * D + 4 * lane + 256 * j) = v[j];
            else { u32x2 o; o.x = cvt_pk_bf16(v[j][0], v[j][1]); o.y = cvt_pk_bf16(v[j][2], v[j][3]); *(u32x2*)(xout16 + (size_t)row * D + 4 * lane + 256 * j) = o; }
            s2 += (v[j][0] * v[j][0] + v[j][1] * v[j][1]) + (v[j][2] * v[j][2] + v[j][3] * v[j][3]); }
        if (hout) {
            const float r2 = rsqrtf(wave_sum(s2) * (1.0f / D) + EPS);
#pragma unroll
            for (int j = 0; j < 8; ++j) { const f32x4 g = *(const f32x4*)(wpre + 4 * lane + 256 * j); const f32x4 yv = v[j] * r2 * g;
                u32x2 o; o.x = cvt_pk_bf16(yv[0], yv[1]); o.y = cvt_pk_bf16(yv[2], yv[3]); *(u32x2*)(hout + (size_t)row * D + 4 * lane + 256 * j) = o; }
        }
#pragma unroll
        for (int j = 0; j < 8; ++j) { yc[j] = yn[j]; xc[j] = xn[j]; }
    }
#undef ROWS_LOAD
}

__device__ __forceinline__ void phase_pooldiff_tile(const Params& p, int g, int pm) {
    const bf16_t* src = (const bf16_t*)p.out + (size_t)T * D + (size_t)T * 1024;
    bf16_t* dst = (bf16_t*)p.out + (size_t)T * D;
    const int win = 2 << g;
    for (int task = threadIdx.x; task < 256 * 32; task += 512) {
        const int t = pm * 256 + (task >> 5), c8 = g * 256 + (task & 31) * 8, pos = t & (SEQ - 1);
        const int cnt = (pos + 1) < win ? (pos + 1) : win;
        float s[8] = {0.f, 0.f, 0.f, 0.f, 0.f, 0.f, 0.f, 0.f}; float c0[8];
        u32x4 wv[16];
#pragma unroll
        for (int k = 0; k < 16; ++k) wv[k] = (k < cnt) ? *(const u32x4*)(src + (size_t)(t - k) * 1024 + c8) : (u32x4){0u, 0u, 0u, 0u};
#pragma unroll
        for (int k = 0; k < 16; ++k) { const u32x4 v = wv[k];
            const float f[8] = {lo_bf(v.x), hi_bf(v.x), lo_bf(v.y), hi_bf(v.y), lo_bf(v.z), hi_bf(v.z), lo_bf(v.w), hi_bf(v.w)};
#pragma unroll
            for (int e = 0; e < 8; ++e) { s[e] += f[e]; if (k == 0) c0[e] = f[e]; } }
        const float inv = 1.0f / (float)cnt;
        u32x4 o; o.x = cvt_pk_bf16(s[0] * inv - c0[0], s[1] * inv - c0[1]); o.y = cvt_pk_bf16(s[2] * inv - c0[2], s[3] * inv - c0[3]);
        o.z = cvt_pk_bf16(s[4] * inv - c0[4], s[5] * inv - c0[5]); o.w = cvt_pk_bf16(s[6] * inv - c0[6], s[7] * inv - c0[7]);
        *(u32x4*)(dst + (size_t)t * 1024 + c8) = o;
    }
}

__device__ __forceinline__ void phase_prep(const Params& p, LAS unsigned char* lds, int bid, int nb) {
    const int tid = threadIdx.x, lane = tid & 63, wid = tid >> 6;
    LAS bf16_t* raw = (LAS bf16_t*)lds;
    LAS bf16_t* qs = (LAS bf16_t*)(lds + 51456);
    LAS bf16_t* ks = qs + 64 * 136;
    LAS bf16_t* vs = ks + 64 * 136;
    LAS bf16_t* M0 = (LAS bf16_t*)lds; LAS bf16_t* M1 = M0 + 4608; LAS bf16_t* M2 = M0 + 2 * 4608; LAS bf16_t* M3 = M0 + 3 * 4608; LAS bf16_t* M4 = M0 + 4 * 4608;
    LAS bf16_t* M5 = (LAS bf16_t*)(lds + 103680); LAS bf16_t* M6 = (LAS bf16_t*)(lds + 127232); LAS bf16_t* M7 = (LAS bf16_t*)(lds + 136448);
    LAS float* Gs = (LAS float*)(lds + 120064);
    LAS float* cwl = (LAS float*)(lds + 121088);
    bf16_t* prep = (bf16_t*)(p.ws + OFF_PREP);
    const float* ab = (const float*)(p.ws + OFF_AB);
    float* cd = (float*)(p.ws + OFF_CD);
    const float* convw = p.in[4];
    u32x4 pf[7]; f32x4 pfc = (f32x4){0.f, 0.f, 0.f, 0.f}; float pfa = 0.f, pfb = 0.f;
    const int cty = tid >> 7, cj = (tid & 127) >> 5, cd4 = (tid & 31) * 4;
    {
#pragma unroll
        for (int k = 0; k < 7; ++k) { const int v = tid + 512 * k; if (v < 3216) pf[k] = ((const u32x4*)(prep + (size_t)bid * SLOT))[v]; }
        const int bh0 = bid >> 7, n0 = bid & 127, hh0 = bh0 & 15;
        if (tid < 384) pfc = *(const f32x4*)(convw + cj * 6144 + cty * 2048 + hh0 * 128 + cd4);
        if (tid < 64) { const int t = (bh0 >> 4) * SEQ + n0 * 64 + tid; pfb = ab[(size_t)t * 32 + hh0]; pfa = ab[(size_t)t * 32 + 16 + hh0]; }
    }
    for (int item = bid; item < 4096; item += nb) {
        const int bh = item >> 7, n = item & 127, b = bh >> 4, hh = bh & 15;
        bf16_t* slot = prep + (size_t)item * SLOT;
#pragma unroll
        for (int k = 0; k < 7; ++k) { const int v = tid + 512 * k; if (v < 3216) ((LAS u32x4*)raw)[v] = pf[k]; }
        if (tid < 384) *(LAS f32x4*)(cwl + (cty * 4 + cj) * 128 + cd4) = pfc;
        if (tid < 64) {
            const float braw = pfb, araw = pfa;
            const float xx = araw + p.in[6][hh];
            const float sp = fmaxf(xx, 0.f) + log1pf(__expf(-fabsf(xx)));
            float G = -__expf(p.in[5][hh]) * sp;
#pragma unroll
            for (int o = 1; o < 64; o <<= 1) { const float t2 = __shfl_up(G, o); if (lane >= o) G += t2; }
            const float Gl = __shfl(G, 63);
            Gs[tid] = G; Gs[64 + tid] = sigmoid_f(braw); Gs[128 + tid] = __expf(G); Gs[192 + tid] = __expf(Gl - G);
            if (tid == 63) cd[item] = __expf(G);
        }
        LDS_BARRIER();
#pragma unroll 1
        for (int it = 0; it < 6; ++it) {
            const int ty = it >> 1, i = (tid >> 4) + 32 * (it & 1), d0 = (tid & 15) * 8;
            float a[8] = {0.f, 0.f, 0.f, 0.f, 0.f, 0.f, 0.f, 0.f};
            u32x4 rvv[4]; f32x4 cc0[4], cc1[4];
#pragma unroll
            for (int j = 0; j < 4; ++j) { rvv[j] = *(const LAS u32x4*)(raw + ty * RAWT + (i + j) * 128 + d0); const LAS float* cwp = cwl + (ty * 4 + j) * 128 + d0; cc0[j] = *(const LAS f32x4*)cwp; cc1[j] = *(const LAS f32x4*)(cwp + 4); }
            LDS_WAIT();
#pragma unroll
            for (int j = 0; j < 4; ++j) {
                if (n > 0 || i + j >= 3) {
                    const u32x4 rv = rvv[j]; const f32x4 c0 = cc0[j], c1 = cc1[j];
                    a[0] += c0[0] * lo_bf(rv.x); a[1] += c0[1] * hi_bf(rv.x); a[2] += c0[2] * lo_bf(rv.y); a[3] += c0[3] * hi_bf(rv.y);
                    a[4] += c1[0] * lo_bf(rv.z); a[5] += c1[1] * hi_bf(rv.z); a[6] += c1[2] * lo_bf(rv.w); a[7] += c1[3] * hi_bf(rv.w);
                }
            }
            float ss = 0.f;
#pragma unroll
            for (int e = 0; e < 8; ++e) { a[e] = silu_f(a[e]); ss += a[e] * a[e]; }
            if (ty < 2) {
                ss = dpp_red16(ss);
                float r = rsqrtf(ss + EPS); if (ty == 0) r *= 0.08838834764831845f;
#pragma unroll
                for (int e = 0; e < 8; ++e) a[e] *= r;
            }
            LAS bf16_t* dstp = (ty == 0 ? qs : (ty == 1 ? ks : vs)) + i * 136 + d0;
            u32x4 o; o.x = cvt_pk_bf16(a[0], a[1]); o.y = cvt_pk_bf16(a[2], a[3]); o.z = cvt_pk_bf16(a[4], a[5]); o.w = cvt_pk_bf16(a[6], a[7]);
            *(LAS u32x4*)dstp = o;
        }
        LDS_BARRIER();
        if (item + nb < 4096) {
#pragma unroll
            for (int k = 0; k < 7; ++k) { const int v = tid + 512 * k; if (v < 3216) pf[k] = ((const u32x4*)(prep + (size_t)(item + nb) * SLOT))[v]; }
            const int it2 = item + nb, bh2 = it2 >> 7, n2 = it2 & 127, hh2 = bh2 & 15;
            if (tid < 384) pfc = *(const f32x4*)(convw + cj * 6144 + cty * 2048 + hh2 * 128 + cd4);
            if (tid < 64) { const int t = (bh2 >> 4) * SEQ + n2 * 64 + tid; pfb = ab[(size_t)t * 32 + hh2]; pfa = ab[(size_t)t * 32 + 16 + hh2]; }
        }
        {
            const int pr = wid >> 2, rt = wid & 3, fr = lane & 15, fq = lane >> 4;
            const LAS bf16_t* Asrc = pr ? qs : ks;
            bf16x8 af[4];
#pragma unroll
            for (int kq = 0; kq < 4; ++kq) af[kq] = *(const LAS bf16x8*)(Asrc + (rt * 16 + fr) * 136 + kq * 32 + fq * 8);
            const int i = rt * 16 + fr; const float Gi = Gs[i], bi = Gs[64 + i];
#pragma unroll
            for (int ct = 0; ct < 4; ++ct) {
                f32x4 d = (f32x4){0.f, 0.f, 0.f, 0.f};
#pragma unroll
                for (int kq = 0; kq < 4; ++kq) { const bf16x8 bfr = *(const LAS bf16x8*)(ks + (ct * 16 + fr) * 136 + kq * 32 + fq * 8); d = __builtin_amdgcn_mfma_f32_16x16x32_bf16(bfr, af[kq], d, 0, 0, 0); }
                const int j0 = ct * 16 + fq * 4;
                f32x4 o;
#pragma unroll
                for (int jj = 0; jj < 4; ++jj) { const int j = j0 + jj; const float dec = __expf(fminf(Gi - Gs[j], 0.f));
                    o[jj] = pr ? ((i >= j) ? dec * d[jj] : 0.f) : ((i > j) ? bi * dec * d[jj] : 0.f); }
                if (pr) { u32x2 w; w.x = cvt_pk_bf16(o[0], o[1]); w.y = cvt_pk_bf16(o[2], o[3]); *(u32x2*)(slot + 32768 + i * 64 + j0) = w; }
                else {
                    u32x2 w; w.x = cvt_pk_bf16(o[0], o[1]); w.y = cvt_pk_bf16(o[2], o[3]);
                    *(LAS u32x2*)(M0 + i * 72 + j0) = w;
                    u32x2 pw; pw.x = cvt_pk_bf16((i == j0 ? 1.f : 0.f) - o[0], (i == j0 + 1 ? 1.f : 0.f) - o[1]);
                    pw.y = cvt_pk_bf16((i == j0 + 2 ? 1.f : 0.f) - o[2], (i == j0 + 3 ? 1.f : 0.f) - o[3]);
                    *(LAS u32x2*)(M6 + i * 72 + j0) = pw;
                    M1[(j0 + 0) * 72 + i] = (bf16_t)(w.x & 0xffffu); M1[(j0 + 1) * 72 + i] = (bf16_t)(w.x >> 16);
                    M1[(j0 + 2) * 72 + i] = (bf16_t)(w.y & 0xffffu); M1[(j0 + 3) * 72 + i] = (bf16_t)(w.y >> 16);
                }
            }
        }
        LDS_BARRIER();
        {
            const int fr = lane & 15, fq = lane >> 4;
            {
#pragma unroll
                for (int tt = 0; tt < 2; ++tt) {
                    const int t = 2 * wid + tt, ti = t >> 2, tj = t & 3;
                    f32x4 acc = (f32x4){0.f, 0.f, 0.f, 0.f};
#pragma unroll
                    for (int kq = 0; kq < 2; ++kq) { const bf16x8 av = *(const LAS bf16x8*)(M0 + (ti * 16 + fr) * 72 + kq * 32 + fq * 8); const bf16x8 bv = *(const LAS bf16x8*)(M1 + (tj * 16 + fr) * 72 + kq * 32 + fq * 8);
                        acc = __builtin_amdgcn_mfma_f32_16x16x32_bf16(av, bv, acc, 0, 0, 0); }
                    u32x2 pk; pk.x = cvt_pk_bf16(acc[0], acc[1]); pk.y = cvt_pk_bf16(acc[2], acc[3]);
                    *(LAS u32x2*)(M3 + (tj * 16 + fr) * 72 + ti * 16 + fq * 4) = pk;
                    M2[(ti * 16 + fq * 4 + 0) * 72 + tj * 16 + fr] = (bf16_t)(pk.x & 0xffffu); M2[(ti * 16 + fq * 4 + 1) * 72 + tj * 16 + fr] = (bf16_t)(pk.x >> 16);
                    M2[(ti * 16 + fq * 4 + 2) * 72 + tj * 16 + fr] = (bf16_t)(pk.y & 0xffffu); M2[(ti * 16 + fq * 4 + 3) * 72 + tj * 16 + fr] = (bf16_t)(pk.y >> 16);
                }
            }
            LDS_BARRIER();
#pragma unroll 1
            for (int k = 1; k <= 5; ++k) {
                LAS bf16_t* Sc = (k & 1) ? M2 : M4; LAS bf16_t* ScT = (k & 1) ? M3 : M5; LAS bf16_t* Sn = (k & 1) ? M4 : M2; LAS bf16_t* SnT = (k & 1) ? M5 : M3;
                LAS bf16_t* Pc = (k & 1) ? M6 : M7; LAS bf16_t* Pn = (k & 1) ? M7 : M6;
                const int ti = wid & 3;
                if (wid < 4) {
                    if (k < 5) {
#pragma unroll 1
                        for (int tj = 0; tj < 4; ++tj) {
                            f32x4 acc = (f32x4){0.f, 0.f, 0.f, 0.f};
#pragma unroll
                            for (int kq = 0; kq < 2; ++kq) { const bf16x8 av = *(const LAS bf16x8*)(Sc + (ti * 16 + fr) * 72 + kq * 32 + fq * 8); const bf16x8 bv = *(const LAS bf16x8*)(ScT + (tj * 16 + fr) * 72 + kq * 32 + fq * 8);
                                acc = __builtin_amdgcn_mfma_f32_16x16x32_bf16(av, bv, acc, 0, 0, 0); }
                            u32x2 pk; pk.x = cvt_pk_bf16(acc[0], acc[1]); pk.y = cvt_pk_bf16(acc[2], acc[3]);
                            *(LAS u32x2*)(SnT + (tj * 16 + fr) * 72 + ti * 16 + fq * 4) = pk;
                            Sn[(ti * 16 + fq * 4 + 0) * 72 + tj * 16 + fr] = (bf16_t)(pk.x & 0xffffu); Sn[(ti * 16 + fq * 4 + 1) * 72 + tj * 16 + fr] = (bf16_t)(pk.x >> 16);
                            Sn[(ti * 16 + fq * 4 + 2) * 72 + tj * 16 + fr] = (bf16_t)(pk.y & 0xffffu); Sn[(ti * 16 + fq * 4 + 3) * 72 + tj * 16 + fr] = (bf16_t)(pk.y >> 16);
                        }
                    }
                } else {
#pragma unroll 1
                    for (int tj = 0; tj < 4; ++tj) {
                        f32x4 acc;
#pragma unroll
                        for (int jj = 0; jj < 4; ++jj) acc[jj] = bf2f(Pc[(ti * 16 + fq * 4 + jj) * 72 + tj * 16 + fr]);
#pragma unroll
                        for (int kq = 0; kq < 2; ++kq) { const bf16x8 av = *(const LAS bf16x8*)(Pc + (ti * 16 + fr) * 72 + kq * 32 + fq * 8); const bf16x8 bv = *(const LAS bf16x8*)(ScT + (tj * 16 + fr) * 72 + kq * 32 + fq * 8);
                            acc = __builtin_amdgcn_mfma_f32_16x16x32_bf16(av, bv, acc, 0, 0, 0); }
                        const unsigned p01 = cvt_pk_bf16(acc[0], acc[1]), p23 = cvt_pk_bf16(acc[2], acc[3]);
                        Pn[(ti * 16 + fq * 4 + 0) * 72 + tj * 16 + fr] = (bf16_t)(p01 & 0xffffu); Pn[(ti * 16 + fq * 4 + 1) * 72 + tj * 16 + fr] = (bf16_t)(p01 >> 16);
                        Pn[(ti * 16 + fq * 4 + 2) * 72 + tj * 16 + fr] = (bf16_t)(p23 & 0xffffu); Pn[(ti * 16 + fq * 4 + 3) * 72 + tj * 16 + fr] = (bf16_t)(p23 >> 16);
                    }
                }
                LDS_BARRIER();
            }
            {
                const LAS bf16_t* Tinv = M7;
                const int ct = wid;
                bf16x8 Xv[2], Xk[2];
#pragma unroll
                for (int kq = 0; kq < 2; ++kq) {
                    const int jb = kq * 32 + fq * 8;
                    const f32x4 b0 = *(const LAS f32x4*)(Gs + 64 + jb), b1 = *(const LAS f32x4*)(Gs + 64 + jb + 4), e0 = *(const LAS f32x4*)(Gs + 128 + jb), e1 = *(const LAS f32x4*)(Gs + 128 + jb + 4);
                    float fv[8], fk[8];
#pragma unroll
                    for (int e = 0; e < 8; ++e) { const float be = e < 4 ? b0[e & 3] : b1[e & 3], ee = e < 4 ? e0[e & 3] : e1[e & 3];
                        fv[e] = bf2f(vs[(jb + e) * 136 + ct * 16 + fr]) * be; fk[e] = bf2f(ks[(jb + e) * 136 + ct * 16 + fr]) * be * ee; }
                    u32x4 pv, pk2; pv.x = cvt_pk_bf16(fv[0], fv[1]); pv.y = cvt_pk_bf16(fv[2], fv[3]); pv.z = cvt_pk_bf16(fv[4], fv[5]); pv.w = cvt_pk_bf16(fv[6], fv[7]);
                    pk2.x = cvt_pk_bf16(fk[0], fk[1]); pk2.y = cvt_pk_bf16(fk[2], fk[3]); pk2.z = cvt_pk_bf16(fk[4], fk[5]); pk2.w = cvt_pk_bf16(fk[6], fk[7]);
                    Xv[kq] = __builtin_bit_cast(bf16x8, pv); Xk[kq] = __builtin_bit_cast(bf16x8, pk2);
                }
#pragma unroll 1
                for (int ti = 0; ti < 4; ++ti) {
                    f32x4 du = (f32x4){0.f, 0.f, 0.f, 0.f}, dk = (f32x4){0.f, 0.f, 0.f, 0.f};
#pragma unroll
                    for (int kq = 0; kq < 2; ++kq) { const bf16x8 ty = *(const LAS bf16x8*)(Tinv + (ti * 16 + fr) * 72 + kq * 32 + fq * 8);
                        du = __builtin_amdgcn_mfma_f32_16x16x32_bf16(Xv[kq], ty, du, 0, 0, 0); dk = __builtin_amdgcn_mfma_f32_16x16x32_bf16(Xk[kq], ty, dk, 0, 0, 0); }
                    const int i = ti * 16 + fr, c0 = ct * 16 + fq * 4;
                    u32x2 wu, wk2; wu.x = cvt_pk_bf16(du[0], du[1]); wu.y = cvt_pk_bf16(du[2], du[3]); wk2.x = cvt_pk_bf16(dk[0], dk[1]); wk2.y = cvt_pk_bf16(dk[2], dk[3]);
                    *(u32x2*)(slot + i * 128 + c0) = wu; *(u32x2*)(slot + 8192 + i * 128 + c0) = wk2;
                }
            }
            for (int v = tid; v < 1024; v += 512) { const int i = v >> 4, d0 = (v & 15) * 8; const u32x4 q = *(const LAS u32x4*)(qs + i * 136 + d0); const float e = Gs[128 + i];
                u32x4 o; o.x = cvt_pk_bf16(lo_bf(q.x) * e, hi_bf(q.x) * e); o.y = cvt_pk_bf16(lo_bf(q.y) * e, hi_bf(q.y) * e); o.z = cvt_pk_bf16(lo_bf(q.z) * e, hi_bf(q.z) * e); o.w = cvt_pk_bf16(lo_bf(q.w) * e, hi_bf(q.w) * e);
                *(u32x4*)(slot + 16384 + i * 128 + d0) = o; }
            for (int v = tid; v < 1024; v += 512) { const int d = v >> 3, i0 = (v & 7) * 8; float f[8];
#pragma unroll
                for (int e = 0; e < 8; ++e) f[e] = bf2f(ks[(i0 + e) * 136 + d]) * Gs[192 + i0 + e];
                u32x4 o; o.x = cvt_pk_bf16(f[0], f[1]); o.y = cvt_pk_bf16(f[2], f[3]); o.z = cvt_pk_bf16(f[4], f[5]); o.w = cvt_pk_bf16(f[6], f[7]);
                *(u32x4*)(slot + 24576 + d * 64 + i0) = o; }
        }
        LDS_BARRIER();
    }
}

__device__ __forceinline__ void phase_scan(const Params& p, LAS unsigned char* lds, int bid) {
    const int tid = threadIdx.x, lane = tid & 63, w = __builtin_amdgcn_readfirstlane(tid >> 6), fr = lane & 15, fq = lane >> 4;
    const int kx = bid >> 3, h32 = (bid & 7) + 8 * (kx >> 3), s = kx & 7, b = h32 >> 4, hh = h32 & 15;
    LAS bf16_t* Wk = (LAS bf16_t*)lds;
    LAS bf16_t* Qd = Wk + 64 * 136;
    LAS bf16_t* KdT = Qd + 64 * 136;
    LAS bf16_t* At = KdT + 128 * 72;
    LAS bf16_t* Uv = At + 64 * 72;
    LAS bf16_t* ST = (LAS bf16_t*)(lds + 64512);
    LAS bf16_t* UT = (LAS bf16_t*)(lds + 68864);
    LAS bf16_t* Ot = (LAS bf16_t*)(lds + 71168);
    const bf16_t* prep = (const bf16_t*)(p.ws + OFF_PREP) + (size_t)h32 * 128 * SLOT;
    const float* cd = (const float*)(p.ws + OFF_CD) + h32 * 128;
    bf16_t* on = (bf16_t*)p.out + (size_t)T * D;
    float* ssq = (float*)(p.ws + OFF_SSQ);
    const int rt = w & 3, which = w >> 2;
    f32x4 Sacc = (f32x4){0.f, 0.f, 0.f, 0.f};
    for (int i = tid; i < 16 * 136 / 2; i += 512) ((LAS unsigned*)ST)[i] = 0u;
    const int urow = tid >> 1, uhalf = tid & 1;
    u32x4 st[7], stu = (u32x4){0u, 0u, 0u, 0u};
#pragma unroll
    for (int k = 0; k < 7; ++k) st[k] = ((const u32x4*)prep)[1024 + tid + 512 * k];
    if (tid < 128) stu = ((const u32x4*)prep)[urow * 16 + s * 2 + uhalf];
    for (int n = 0; n < 128; ++n) {
        LDS_BARRIER();
        if (n > 0 && tid < 128) *(u32x4*)(on + (size_t)(b * SEQ + (n - 1) * 64 + urow) * D + hh * 128 + s * 16 + uhalf * 8) = *(const LAS u32x4*)(Ot + urow * 16 + uhalf * 8);
#pragma unroll
        for (int k = 0; k < 7; ++k) {
            const int v = tid + 512 * k;
            LAS bf16_t* dp;
            if (k < 2) dp = Wk + (v >> 4) * 136 + (v & 15) * 8;
            else if (k < 4) dp = Qd + ((v - 1024) >> 4) * 136 + (v & 15) * 8;
            else if (k < 6) dp = KdT + ((v - 2048) >> 3) * 72 + (v & 7) * 8;
            else dp = At + ((v - 3072) >> 3) * 72 + (v & 7) * 8;
            *(LAS u32x4*)dp = st[k];
        }
        if (tid < 128) *(LAS u32x4*)(Uv + urow * 16 + uhalf * 8) = stu;
        const float cdv = cd[n];
        LDS_BARRIER();
        if (n + 1 < 128) {
            const u32x4* nx = (const u32x4*)(prep + (size_t)(n + 1) * SLOT);
#pragma unroll
            for (int k = 0; k < 7; ++k) st[k] = nx[1024 + tid + 512 * k];
            if (tid < 128) stu = nx[urow * 16 + s * 2 + uhalf];
        }
        f32x4 X = (f32x4){0.f, 0.f, 0.f, 0.f};
        bf16x8 aK[2], aA[2];
        {
            const LAS bf16_t* Asrc = (which ? Qd : Wk) + (rt * 16 + fr) * 136 + fq * 8;
            bf16x8 bSv[4], av[4];
#pragma unroll
            for (int kq = 0; kq < 4; ++kq) { bSv[kq] = *(const LAS bf16x8*)(ST + fr * 136 + kq * 32 + fq * 8); av[kq] = *(const LAS bf16x8*)(Asrc + kq * 32); }
            float uvv[4];
#pragma unroll
            for (int jj = 0; jj < 4; ++jj) uvv[jj] = bf2f(Uv[(rt * 16 + fq * 4 + jj) * 16 + fr]);
#pragma unroll
            for (int kc = 0; kc < 2; ++kc) { aK[kc] = *(const LAS bf16x8*)(KdT + (w * 16 + fr) * 72 + kc * 32 + fq * 8); aA[kc] = *(const LAS bf16x8*)(At + (rt * 16 + fr) * 72 + kc * 32 + fq * 8); }
            LDS_WAIT();
#pragma unroll
            for (int kq = 0; kq < 4; ++kq) X = __builtin_amdgcn_mfma_f32_16x16x32_bf16(av[kq], bSv[kq], X, 0, 0, 0);
            if (which == 0) {
                u32x2 pk; pk.x = cvt_pk_bf16(uvv[0] - X[0], uvv[1] - X[1]); pk.y = cvt_pk_bf16(uvv[2] - X[2], uvv[3] - X[3]);
                *(LAS u32x2*)(UT + fr * 72 + rt * 16 + fq * 4) = pk;
            }
        }
        LDS_BARRIER();
        bf16x8 bU[2];
#pragma unroll
        for (int kc = 0; kc < 2; ++kc) bU[kc] = *(const LAS bf16x8*)(UT + fr * 72 + kc * 32 + fq * 8);
        LDS_WAIT();
        Sacc *= cdv;
#pragma unroll
        for (int kc = 0; kc < 2; ++kc) Sacc = __builtin_amdgcn_mfma_f32_16x16x32_bf16(aK[kc], bU[kc], Sacc, 0, 0, 0);
        if (which == 1) {
#pragma unroll
            for (int kc = 0; kc < 2; ++kc) X = __builtin_amdgcn_mfma_f32_16x16x32_bf16(aA[kc], bU[kc], X, 0, 0, 0);
            float sq[4];
#pragma unroll
            for (int jj = 0; jj < 4; ++jj) sq[jj] = dpp_red16(X[jj] * X[jj]);
            if (fr == 0) {
#pragma unroll
                for (int jj = 0; jj < 4; ++jj) ssq[(size_t)(b * SEQ + n * 64 + rt * 16 + fq * 4 + jj) * 128 + hh * 8 + s] = sq[jj];
            }
#pragma unroll
            for (int jj = 0; jj < 4; ++jj) Ot[(rt * 16 + fq * 4 + jj) * 16 + fr] = (bf16_t)(cvt_pk_bf16(X[jj], 0.f) & 0xffffu);
        }
        { u32x2 pk; pk.x = cvt_pk_bf16(Sacc[0], Sacc[1]); pk.y = cvt_pk_bf16(Sacc[2], Sacc[3]); *(LAS u32x2*)(ST + fr * 136 + w * 16 + fq * 4) = pk; }
    }
    LDS_BARRIER();
    if (tid < 128) *(u32x4*)(on + (size_t)(b * SEQ + 127 * 64 + urow) * D + hh * 128 + s * 16 + uhalf * 8) = *(const LAS u32x4*)(Ot + urow * 16 + uhalf * 8);
}


#define XB_TMO      128
#define XB_XCNT(j)  (256  + 64 * (j))
#define XB_XSUB(j)  (1280 + 64 * (j))
#define XB_XGEN(j)  (2304 + 64 * (j))
#define XB_TOP      3328
#define XB_TOPGEN   3392
#define XCD_BAR_WORDS 3456
#define XB_SPIN_CAP (1u << 18)
__device__ __forceinline__ unsigned xb_ld(unsigned* p)              { return __hip_atomic_load(p, __ATOMIC_RELAXED, __HIP_MEMORY_SCOPE_AGENT); }
__device__ __forceinline__ unsigned xb_add(unsigned* p, unsigned v) { return __hip_atomic_fetch_add(p, v, __ATOMIC_RELAXED, __HIP_MEMORY_SCOPE_AGENT); }
__device__ __forceinline__ unsigned xb_xcc_id() { return (unsigned)__builtin_amdgcn_s_getreg((3 << 11) | 20) & 0xFu; }
#define XB_SPIN(cond, bar) do { unsigned _sp = 0; while (cond) { __builtin_amdgcn_s_sleep(1); \
    if ((++_sp & 255u) == 0u) { if (xb_ld(&(bar)[XB_TMO])) break; if (_sp > XB_SPIN_CAP) { atomicAdd(&(bar)[XB_TMO], 1u); break; } } } } while (0)
struct XcdBarrier { unsigned* bar; unsigned x; volatile LAS unsigned* st; };
__device__ __forceinline__ XcdBarrier xcd_barrier_post(unsigned* bar, volatile LAS unsigned* st) {
    XcdBarrier b; b.bar = bar; b.x = xb_xcc_id(); b.st = st;
    if (threadIdx.x == 0) (void)xb_add(&bar[XB_XCNT(b.x)], 1u);
    return b;
}
__device__ __forceinline__ void xcd_barrier_complete(unsigned* bar, unsigned x, unsigned& nloc, unsigned& nx) {
    const unsigned G = gridDim.x * gridDim.y * gridDim.z;
    unsigned sum, cnt, mine, sp = 0u;
    for (;;) {
        sum = 0u; cnt = 0u; mine = 0u;
#pragma unroll
        for (unsigned j = 0; j < 16; ++j) { const unsigned c = xb_ld(&bar[XB_XCNT(j)]); sum += c; cnt += (c > 0u) ? 1u : 0u; mine = (j == x) ? c : mine; }
        if (sum == G) break;
        __builtin_amdgcn_s_sleep(1);
        if ((++sp & 255u) == 0u) { if (xb_ld(&bar[XB_TMO])) break; if (sp > XB_SPIN_CAP) { atomicAdd(&bar[XB_TMO], 1u); break; } }
    }
    nloc = mine > 0u ? mine : 1u; nx = cnt > 0u ? cnt : 1u;
}
__device__ __forceinline__ void xcd_barrier(const XcdBarrier& b) {
    asm volatile("s_waitcnt vmcnt(0)" ::: "memory");
    __syncthreads();
    if (threadIdx.x == 0) {
        unsigned* bar = b.bar;
        __builtin_amdgcn_s_waitcnt(0);
        unsigned nloc = b.st[0], nx = b.st[1];
        if (nloc == 0u) { xcd_barrier_complete(bar, b.x, nloc, nx); b.st[0] = nloc; b.st[1] = nx; }
        const unsigned old = xb_add(&bar[XB_XSUB(b.x)], 1u);
        const unsigned gen = old / nloc;
        if (old + 1u == (gen + 1u) * nloc) {
            __builtin_amdgcn_fence(__ATOMIC_RELEASE, "agent");
            asm volatile("s_waitcnt vmcnt(0)" ::: "memory");
            const unsigned og = xb_add(&bar[XB_TOP], 1u);
            const unsigned tg = og / nx;
            if (og + 1u == (tg + 1u) * nx) xb_add(&bar[XB_TOPGEN], 1u);
            else XB_SPIN(xb_ld(&bar[XB_TOPGEN]) == tg, bar);
            __builtin_amdgcn_fence(__ATOMIC_ACQUIRE, "agent");
            xb_add(&bar[XB_XGEN(b.x)], 1u);
            asm volatile("s_waitcnt vmcnt(0)" ::: "memory");
        } else {
            XB_SPIN(xb_ld(&bar[XB_XGEN(b.x)]) == gen, bar);
            __builtin_amdgcn_fence(__ATOMIC_ACQUIRE, "agent");
            asm volatile("s_waitcnt vmcnt(0)" ::: "memory");
        }
    }
    __syncthreads();
}

enum { ST_CONV0 = 0, ST_QKV, ST_PREP, ST_SCAN, ST_Z, ST_GA, ST_BA, ST_MIX, ST_ROW1, ST_XQ, ST_SM, ST_XO, ST_ROW2, ST_UP, ST_DOWN, ST_ROW3, ST_COUNT };
__host__ __device__ inline bool sync_after(int st) { return !(st == ST_Z); }

__device__ __forceinline__ void job_init(GJob& j, const void* A, int lda, const void* B, int ldb, int K, int nM, int nN, int bid, int nb) {
    j.A = (const char*)A; j.B = (const char*)B; j.sA1 = j.sA2 = j.sB1 = j.sB2 = 0; j.lda = lda; j.ldb = ldb; j.K = K; j.nM = nM; j.nN = nN; j.G1 = 1; j.G2 = 1;
    j.rstride = 256; j.orow0 = 0; j.oR1 = j.oR2 = j.oC1 = j.oC2 = 0; j.G = nb; j.c = bid; j.direct = 0;
}

#ifndef STEP_MASK
#define STEP_MASK 0xffffffffu
#endif
#define STEP_BEGIN(k) if (((STEP_MASK >> (k)) & 1u) && p.st_lo <= (k) && (k) < p.st_hi) {
#define STEP_END(k) if ((k) + 1 < p.st_hi && sync_after(k)) xcd_barrier(xb); }
#define GEMM_B(k, Aptr, lda_, Bptr, ldb_, K_, nM_, nN_, SETUP, Optr, ldc_, mode_, aux1_, aux2_, cs_) STEP_BEGIN(k) { GJob j; job_init(j, Aptr, lda_, Bptr, ldb_, K_, nM_, nN_, bid, nb); SETUP; \
    EpiB e; e.O = (bf16_t*)(Optr); e.ldc = ldc_; e.mode = mode_; e.aux1 = (const bf16_t*)(aux1_); e.aux2 = (const bf16_t*)(aux2_); e.cscale = cs_; e.ssq = (const float*)(ws + OFF_SSQ); e.gn = p.in[7]; pg8::gemm_phase<EpiB>(lds, j, e); } STEP_END(k)
#define GEMM_F(k, Aptr, lda_, Bptr, ldb_, K_, nM_, nN_, Cptr) STEP_BEGIN(k) { GJob j; job_init(j, Aptr, lda_, Bptr, ldb_, K_, nM_, nN_, bid, nb); \
    EpiF e; e.C = (float*)(Cptr); e.ldc = 2048; pg8::gemm_phase<EpiF>(lds, j, e); } STEP_END(k)

__global__ void __launch_bounds__(512, 2) mega(Params p) {
    extern __shared__ __attribute__((aligned(16))) unsigned char smem[];
    LAS unsigned char* lds = (LAS unsigned char*)smem;
    cg::grid_group grid = cg::this_grid();
    const int bid = blockIdx.x, nb = gridDim.x;
    unsigned char* const ws = p.ws;
    bf16_t* const Hb = (bf16_t*)p.out; bf16_t* const ON = (bf16_t*)p.out + (size_t)T * D;
    const float* const nullf = nullptr;
    volatile LAS unsigned* xbst = (volatile LAS unsigned*)(lds + LDS_BYTES - 16);
    if (threadIdx.x == 0) { xbst[0] = 0u; xbst[1] = 0u; xbst[2] = 0u; xbst[3] = 0u; }
    __syncthreads();
    XcdBarrier xb = xcd_barrier_post((unsigned*)(ws + OFF_BAR), xbst);
    if (p.st_hi > 1000) grid.sync();
    STEP_BEGIN(ST_CONV0) phase_convert0(p, lds, bid, nb); STEP_END(ST_CONV0)
    STEP_BEGIN(ST_QKV) {
        { GJob j; job_init(j, Hb, 4096, ws + OFF_W0, 4096, 2048, 64, 29, bid, nb); EpiQKV e; e.prep = (bf16_t*)(ws + OFF_PREP); e.ab = (float*)(ws + OFF_AB); e.poola = (bf16_t*)p.out + (size_t)T * D + (size_t)T * 1024; pg8::gemm_phase<EpiQKV>(lds, j, e); }
        EpiB e; e.mode = 0; e.aux1 = nullptr; e.aux2 = nullptr; e.cscale = nullptr; e.ssq = nullptr; e.gn = nullptr;
        { GJob j; job_init(j, ws + OFF_M, 4096, ws + OFF_WXKV, 4096, 2048, 2, 8, (bid + nb / 2) % nb, nb); e.O = (bf16_t*)(ws + OFF_KM); e.ldc = 2048; pg8::gemm_phase<EpiB>(lds, j, e); }
        { GJob j; job_init(j, ws + OFF_WXKV + (size_t)2048 * 4096, 4096, ws + OFF_M, 4096, 2048, 8, 2, (bid + 3 * nb / 4) % nb, nb); e.O = (bf16_t*)(ws + OFF_VT); e.ldc = 512; pg8::gemm_phase<EpiB>(lds, j, e); }
        { GJob j; job_init(j, Hb, 4096, ws + OFF_WGB, 4096, 2048, 64, 8, bid, nb); e.O = (bf16_t*)(ws + OFF_YB); e.ldc = 2048; e.mode = 5; pg8::gemm_phase<EpiB>(lds, j, e); }
        { const int frank = (bid >= 80 && bid < 128) ? bid - 80 : ((bid >= 144 && bid < 256) ? bid - 144 + 48 : -1);
          if (frank >= 0) { LookupDeferred lk; lk.p = &p; transpose_stream(lk, frank * 8 + (int)(threadIdx.x >> 6), 160 * 8, (LAS float*)(lds + (threadIdx.x >> 6) * 8448), (int)(threadIdx.x & 63)); } }
    } STEP_END(ST_QKV)
    STEP_BEGIN(ST_PREP) {
        phase_prep(p, lds, bid, nb);
        if (bid < 256) phase_pooldiff_tile(p, bid >> 6, bid & 63);
        asm volatile("s_waitcnt vmcnt(0)" ::: "memory"); __syncthreads();
        GJob j; job_init(j, ON, 2048, ws + OFF_WPOOL, 512, 256, 64, 1, bid, nb); j.direct = 1; j.G1 = 4; j.sA1 = 512; j.sB1 = 256 * 512; j.oC1 = 256;
        EpiB e; e.O = (bf16_t*)(ws + OFF_POOLA); e.ldc = 1024; e.mode = 4; e.aux1 = nullptr; e.aux2 = nullptr; e.cscale = p.in[9]; e.ssq = nullptr; e.gn = nullptr; pg8::gemm_phase<EpiB>(lds, j, e);
    } STEP_END(ST_PREP)
    STEP_BEGIN(ST_SCAN) {
        phase_scan(p, lds, bid);
        GJob j; job_init(j, ws + OFF_POOLA, 2048, ws + OFF_WB, 2048, 1024, 64, 8, bid, nb);
        EpiB e; e.O = (bf16_t*)(ws + OFF_YB); e.ldc = 2048; e.mode = 6; e.aux1 = (const bf16_t*)(ws + OFF_YB); e.aux2 = nullptr; e.cscale = nullptr; e.ssq = nullptr; e.gn = nullptr; pg8::gemm_phase<EpiB>(lds, j, e);
    } STEP_END(ST_SCAN)
    GEMM_B(ST_Z, Hb, 4096, ws + OFF_WZ, 4096, 2048, 64, 8, (void)0, ON, 2048, 1, ON, nullptr, nullf)
    GEMM_B(ST_GA, Hb, 4096, ws + OFF_WGA, 4096, 2048, 64, 8, (void)0, ws + OFF_YA, 2048, 5, nullptr, nullptr, nullf)
    GEMM_B(ST_BA, ON, 4096, ws + OFF_WA, 4096, 2048, 64, 8, (void)0, ws + OFF_YA, 2048, 7, ws + OFF_YA, ws + OFF_YB, nullf)
    GEMM_B(ST_MIX, ws + OFF_YA, 4096, ws + OFF_WMIX, 4096, 2048, 64, 8, (void)0, ws + OFF_Y, 2048, 0, nullptr, nullptr, nullf)
    STEP_BEGIN(ST_ROW1) phase_rows((const bf16_t*)(ws + OFF_Y), p.in[0], nullptr, nullptr, (bf16_t*)(ws + OFF_XB), p.in[13], p.in[14], (bf16_t*)(ws + OFF_H2), bid * 8 + (threadIdx.x >> 6), nb * 8, threadIdx.x & 63); phase_convert_late(p, lds, bid, nb); STEP_END(ST_ROW1)
    GEMM_B(ST_XQ, ws + OFF_H2, 4096, ws + OFF_WXQ, 4096, 2048, 64, 8, (void)0, ws + OFF_Q, 2048, 0, nullptr, nullptr, nullf)
    STEP_BEGIN(ST_SM) {
        { GJob j; job_init(j, ws + OFF_Q, 4096, ws + OFF_KM, 4096, 512, 32, 1, bid, nb); j.direct = 1; j.G1 = 2; j.G2 = 4; j.sA1 = (long)SEQ * 4096; j.sA2 = 1024; j.sB1 = 256 * 4096; j.sB2 = 1024; j.oR1 = 4 * SEQ; j.oR2 = SEQ;
          EpiSM e; e.P = (bf16_t*)(ws + OFF_P); pg8::gemm_phase<EpiSM>(lds, j, e); }
        { GJob j; job_init(j, ws + OFF_P, 512, ws + OFF_VT, 1024, 256, 32, 2, bid, nb); j.direct = 2; j.G1 = 2; j.G2 = 4; j.sA1 = (long)4 * SEQ * 512; j.sA2 = (long)SEQ * 512; j.sB1 = 512; j.sB2 = 512 * 1024; j.oR1 = SEQ; j.oC2 = 512;
          EpiB e; e.O = (bf16_t*)(ws + OFF_O); e.ldc = 2048; e.mode = 0; e.aux1 = nullptr; e.aux2 = nullptr; e.cscale = nullptr; e.ssq = nullptr; e.gn = nullptr; pg8::gemm_phase<EpiB>(lds, j, e); }
    } STEP_END(ST_SM)
    GEMM_B(ST_XO, ws + OFF_O, 4096, ws + OFF_WXO, 4096, 2048, 64, 8, (void)0, ws + OFF_Y, 2048, 0, nullptr, nullptr, nullf)
    STEP_BEGIN(ST_ROW2) phase_rows((const bf16_t*)(ws + OFF_Y), nullptr, (const bf16_t*)(ws + OFF_XB), nullptr, (bf16_t*)(ws + OFF_XB), p.in[19], p.in[20], (bf16_t*)(ws + OFF_H3), bid * 8 + (threadIdx.x >> 6), nb * 8, threadIdx.x & 63); STEP_END(ST_ROW2)
    STEP_BEGIN(ST_UP) { GJob j; job_init(j, ws + OFF_H3 - 2 * 4096, 4096, ws + OFF_WUP, 4096, 2048, 65, 43, bid, nb); j.rstride = 254; j.orow0 = -2;
        EpiCG e; e.act = (bf16_t*)(ws + OFF_ACT); e.cw = p.in[22]; e.cb = p.in[23]; pg8::gemm_phase<EpiCG>(lds, j, e); } STEP_END(ST_UP)
    GEMM_B(ST_DOWN, ws + OFF_ACT, 11008, ws + OFF_WDOWN, 11008, 5504, 64, 8, (void)0, ws + OFF_YDOWN, 2048, 0, nullptr, nullptr, nullf)
    STEP_BEGIN(ST_ROW3) phase_rows((const bf16_t*)(ws + OFF_YDOWN), nullptr, (const bf16_t*)(ws + OFF_XB), p.out, nullptr, p.in[25], nullptr, nullptr, bid * 8 + (threadIdx.x >> 6), nb * 8, threadIdx.x & 63); STEP_END(ST_ROW3)
#ifdef DBG_CK
    {
        unsigned* ckw = (unsigned*)(ws + 511 * MiB);
        grid.sync();
        if (bid == 0 && threadIdx.x == 0) __hip_atomic_store(ckw, 0u, __ATOMIC_RELAXED, __HIP_MEMORY_SCOPE_AGENT);
        grid.sync();
        const unsigned* reg = (const unsigned*)(ws + DBG_CK_OFF);
        unsigned s = 0;
        for (size_t i = (size_t)bid * 512 + threadIdx.x; i < (size_t)DBG_CK_WORDS; i += (size_t)nb * 512) {
            bool use = true;
#ifdef DBG_CK_RAWONLY
            { const size_t el = (2 * i) % SLOT; use = el < 3 * RAWT && (el % RAWT) >= 384; }
#endif
            if (use) s += reg[i] * (unsigned)(2 * i + 1);
        }
        atomicAdd(ckw, s);
        grid.sync();
        const unsigned ck = __hip_atomic_load(ckw, __ATOMIC_RELAXED, __HIP_MEMORY_SCOPE_AGENT);
        for (size_t i = (size_t)bid * 512 + threadIdx.x; i < (size_t)T * D; i += (size_t)nb * 512) { unsigned h = (ck ^ (unsigned)i) * 2654435761u; h ^= h >> 15; h *= 2246822519u; h ^= h >> 13; p.out[i] = (float)(h & 0xffffu) * (1.0f / 65536.0f); }
    }
#endif
}

extern "C" void kernel_launch(void* const* d_in, const int* in_sizes, int n_in, void* d_out, int out_size, void* d_ws, size_t ws_size, hipStream_t stream) {
    static int grid_blocks = 0;
    if (!grid_blocks) {
        if (n_in != 26 || out_size != T * D || ws_size < WS_NEED) { fprintf(stderr, "kernel_launch: unexpected shapes (n_in %d out %d ws %zu)\n", n_in, out_size, ws_size); grid_blocks = -1; return; }
        int dev = 0, cus = 0, per_cu = 0;
        hipGetDevice(&dev);
        hipDeviceGetAttribute(&cus, hipDeviceAttributeMultiprocessorCount, dev);
        hipFuncSetAttribute((const void*)mega, hipFuncAttributeMaxDynamicSharedMemorySize, LDS_BYTES);
        hipOccupancyMaxActiveBlocksPerMultiprocessor(&per_cu, (const void*)mega, 512, LDS_BYTES);
        if (per_cu < 1) per_cu = 1;
        grid_blocks = cus * 1;
        (void)hipGetLastError();
    }
    if (grid_blocks < 0) return;
    Params p{};
    for (int i = 0; i < 26; ++i) p.in[i] = (const float*)d_in[i];
    p.out = (float*)d_out; p.ws = (unsigned char*)d_ws;
#if ONE_LAUNCH
    p.st_lo = 0; p.st_hi = ST_COUNT;
    if (hipMemsetAsync((unsigned char*)d_ws + OFF_BAR, 0, XCD_BAR_WORDS * 4, stream) != hipSuccess) { fprintf(stderr, "kernel_launch: memset of the barrier words failed\n"); return; }
    void* args[] = {&p};
    hipError_t e = hipLaunchCooperativeKernel((const void*)mega, dim3(grid_blocks), dim3(512), args, LDS_BYTES, stream);
    if (e != hipSuccess) fprintf(stderr, "cooperative launch failed: %s (grid %d)\n", hipGetErrorString(e), grid_blocks);
#else
    int lo = 0;
    for (int st = 0; st < ST_COUNT; ++st) {
        if (sync_after(st) || st == ST_COUNT - 1) {
            p.st_lo = lo; p.st_hi = st + 1;
            hipLaunchKernelGGL(mega, dim3(grid_blocks), dim3(512), LDS_BYTES, stream, p);
            lo = st + 1;
        }
    }
#endif
}
```
